# Optimizing an MI355X kernel written in HIP

```python
import jax, jax.numpy as jnp
from jax import lax
import numpy as np

D_MODEL = 1024
BATCH = 8
SEQ = 2048
DEPTH = 2

CHUNK = 64
N_META = 16
META_PAD = CHUNK - N_META
HEAD_DIM = 64
A_HEADS = 8
IDX_HEADS = 8
IDX_DIM = 64
DSA_MAX_K = 256
A_QBLK = 64
B_HEADS = 8
B_VDIM = 2 * HEAD_DIM
C_HEADS = 8
C_KV_HEADS = 2
C_WINDOW = 128
C_WIN_CHUNKS = C_WINDOW // CHUNK
D_WIDTH = 512
POOL_WINDOWS = (2, 4, 8, 16)
D_GROUP = D_WIDTH // len(POOL_WINDOWS)
D_FF = 2816
EPS = 1e-6
NEG = -1e30

EVEN_SIZES = ([A_HEADS * HEAD_DIM] * 3 + [IDX_HEADS * IDX_DIM, IDX_DIM, IDX_HEADS]
              + [B_HEADS * HEAD_DIM] * 2 + [B_HEADS * B_VDIM] * 2)
EVEN_IN = sum(EVEN_SIZES)
EVEN_OUT = A_HEADS * HEAD_DIM + B_HEADS * B_VDIM
ODD_SIZES = [C_HEADS * HEAD_DIM, C_KV_HEADS * HEAD_DIM, C_KV_HEADS * HEAD_DIM, D_WIDTH]
ODD_IN = sum(ODD_SIZES)
ODD_OUT = C_HEADS * HEAD_DIM + D_WIDTH
N_EVEN = (DEPTH + 1) // 2
N_ODD = DEPTH // 2

kernel_name = "hybrid_streaming_dsa_retention_swa_pool"


def rms_norm(x, gain=None):
    xf = x.astype(jnp.float32)
    y = xf * lax.rsqrt(jnp.mean(xf * xf, axis=-1, keepdims=True) + EPS)
    if gain is not None:
        y = y * gain.astype(jnp.float32)
    return y.astype(x.dtype)


def swiglu(x, w_in, w_out):
    g, u = jnp.split(x @ w_in, 2, axis=-1)
    return (jax.nn.silu(g) * u) @ w_out


def split_cols(a, sizes):
    out, off = [], 0
    for s in sizes:
        out.append(a[..., off:off + s])
        off += s
    return out


def chunk_ids(n):
    return (jnp.arange(n) + META_PAD) // CHUNK


def pad_left(a):
    return jnp.pad(a, [(0, 0), (META_PAD, 0)] + [(0, 0)] * (a.ndim - 2))


def dsa_attention(q, k, v, iq, ik, iw, top_k):
    B, L, H, dh = q.shape
    cid = chunk_ids(L)
    nb = -(-L // A_QBLK)
    padn = nb * A_QBLK - L

    def blocks(a):
        a = jnp.pad(a, [(0, 0), (0, padn)] + [(0, 0)] * (a.ndim - 2))
        return jnp.moveaxis(a.reshape((B, nb, A_QBLK) + a.shape[2:]), 1, 0)

    q_cid = chunk_ids(nb * A_QBLK).reshape(nb, A_QBLK)
    iw = iw * (IDX_HEADS ** -0.5 * IDX_DIM ** -0.5)
    gather = jax.vmap(lambda t, i: t[i])

    def one_block(args):
        qb, iqb, iwb, qc = args
        logits = jnp.einsum('bqhd,bsd->bqhs', iqb, ik)
        score = jnp.einsum('bqh,bqhs->bqs', iwb, jax.nn.relu(logits)).astype(jnp.float32)
        adm = cid[None, :] <= qc[:, None]
        score = jnp.where(adm[None], score, NEG)
        _, idx = lax.top_k(score, top_k)
        valid = cid[idx] <= qc[None, :, None]
        kg = gather(k, idx)
        vg = gather(v, idx)
        s = jnp.einsum('bqhd,bqkhd->bhqk', qb, kg).astype(jnp.float32) * dh ** -0.5
        s = jnp.where(valid[:, None], s, NEG)
        p = jax.nn.softmax(s, axis=-1).astype(v.dtype)
        return jnp.einsum('bhqk,bqkhd->bqhd', p, vg)

    out = lax.map(one_block, (blocks(q), blocks(iq), blocks(iw), q_cid))
    return jnp.moveaxis(out, 0, 1).reshape(B, nb * A_QBLK, H, dh)[:, :L]


def rotary(x, pos):
    d = x.shape[-1]
    inv = 1.0 / (10000.0 ** (jnp.arange(0, d, 2, dtype=jnp.float32) / d))
    ang = pos.astype(jnp.float32)[:, None] * inv[None]
    cos = jnp.cos(ang)[None, :, None, :]
    sin = jnp.sin(ang)[None, :, None, :]
    x1, x2 = jnp.split(x.astype(jnp.float32), 2, axis=-1)
    return jnp.concatenate([x1 * cos - x2 * sin, x1 * sin + x2 * cos], axis=-1).astype(x.dtype)


def retention(q, k, v):
    B, Lp, H, dk = q.shape
    dv = v.shape[-1]
    N = Lp // CHUNK
    pos = jnp.arange(Lp) - META_PAD
    q = rotary(q, pos)
    k = rotary(k, pos) * dk ** -0.5
    log_g = jnp.log(1.0 - 2.0 ** (-5.0 - jnp.arange(H, dtype=jnp.float32)))
    i = jnp.arange(CHUNK, dtype=jnp.float32)
    rel = i[:, None] - i[None, :]
    dmat = jnp.where(rel >= 0, jnp.exp(jnp.maximum(rel, 0.0)[None] * log_g[:, None, None]), 0.0)
    q_dec = jnp.exp((i + 1.0)[:, None] * log_g[None])
    k_dec = jnp.exp((CHUNK - 1.0 - i)[:, None] * log_g[None])
    c_dec = jnp.exp(CHUNK * log_g)
    qc = q.reshape(B, N, CHUNK, H, dk)
    kc = k.reshape(B, N, CHUNK, H, dk)
    vc = v.reshape(B, N, CHUNK, H, dv)
    inner = jnp.einsum('bnihd,bnjhd->bnhij', qc, kc) * dmat.astype(q.dtype)
    inner = jnp.einsum('bnhij,bnjhe->bnihe', inner, vc)

    def step(S, xs):
        qn, kn, vn = xs
        cross = jnp.einsum('bihd,bhde->bihe', qn, S) * q_dec[None, :, :, None]
        S = S * c_dec[None, :, None, None] + jnp.einsum(
            'bjhd,bjhe->bhde', kn * k_dec[None, :, :, None], vn)
        return S, cross

    S0 = jnp.zeros((B, H, dk, dv), jnp.float32)
    _, cross = lax.scan(step, S0, (jnp.moveaxis(qc, 1, 0), jnp.moveaxis(kc, 1, 0),
                                   jnp.moveaxis(vc, 1, 0)))
    out = inner + jnp.moveaxis(cross, 0, 1).astype(inner.dtype)
    return out.reshape(B, Lp, H, dv)


def swa_sinks(q, k, v, sinks):
    B, Lp, H, dh = q.shape
    G = k.shape[2]
    R = H // G
    N = Lp // CHUNK
    W = C_WIN_CHUNKS

    def band(t):
        tc = t.reshape(B, N, CHUNK, G, dh)
        tp = jnp.pad(tc, ((0, 0), (W, 0), (0, 0), (0, 0), (0, 0)))
        bnd = jnp.concatenate([tp[:, j:j + N] for j in range(W + 1)], axis=2)
        meta = jnp.broadcast_to(t[:, META_PAD:CHUNK][:, None], (B, N, N_META, G, dh))
        return jnp.concatenate([meta, bnd], axis=2)

    kb, vb = band(k), band(v)
    key_chunk = jnp.arange(N)[:, None] - W + (jnp.arange((W + 1) * CHUNK) // CHUNK)[None]
    valid = jnp.concatenate([jnp.ones((N, N_META), bool), key_chunk >= 1], axis=1)
    qg = q.reshape(B, N, CHUNK, G, R, dh)
    s = jnp.einsum('bncgrd,bnkgd->bngrck', qg, kb).astype(jnp.float32) * dh ** -0.5
    s = jnp.where(valid[None, :, None, None, None, :], s, NEG)
    sink = jnp.broadcast_to(sinks.reshape(G, R).astype(jnp.float32)[None, None, :, :, None, None],
                            s.shape[:-1] + (1,))
    p = jax.nn.softmax(jnp.concatenate([s, sink], axis=-1), axis=-1)[..., :-1].astype(v.dtype)
    out = jnp.einsum('bngrck,bnkgd->bncgrd', p, vb)
    return out.reshape(B, Lp, H, dh)


def pool_mixer(x, d_mix, d_scale):
    B, L, _ = x.shape
    xg = x.astype(jnp.float32).reshape(B, L, len(POOL_WINDOWS), D_GROUP)
    cs = jnp.pad(jnp.cumsum(xg, axis=1), ((0, 0), (1, 0), (0, 0), (0, 0)))
    t = jnp.arange(L)
    pooled = []
    for gi, w in enumerate(POOL_WINDOWS):
        c = cs[:, :, gi]
        lag = jnp.pad(c, ((0, 0), (w, 0), (0, 0)))[:, 1:L + 1]
        cnt = jnp.minimum(t + 1, w).astype(jnp.float32)[None, :, None]
        pooled.append((c[:, 1:] - lag) / cnt)
    pooled = jnp.stack(pooled, axis=2)
    y = (pooled - xg).astype(x.dtype)
    y = jnp.einsum('blgc,gce->blge', y, d_mix).reshape(B, L, D_WIDTH)
    return y * d_scale


def even_mixer(h, w_in, a_qn, a_kn, w_out, top_k):
    B, L, _ = h.shape
    aq, ak, av, iq, ik, iw, bq, bk, bv, bg = split_cols(h @ w_in, EVEN_SIZES)
    hd = lambda t, n: t.reshape(B, L, n, -1)
    aq = rms_norm(hd(aq, A_HEADS), a_qn)
    ak = rms_norm(hd(ak, A_HEADS), a_kn)
    ya = dsa_attention(aq, ak, hd(av, A_HEADS), hd(iq, IDX_HEADS), ik, iw, top_k)
    ya = ya.reshape(B, L, -1)
    yb = retention(pad_left(hd(bq, B_HEADS)), pad_left(hd(bk, B_HEADS)),
                   pad_left(hd(bv, B_HEADS)))[:, META_PAD:]
    yb = rms_norm(yb).astype(h.dtype).reshape(B, L, -1) * jax.nn.silu(bg)
    return jnp.concatenate([ya, yb], axis=-1) @ w_out


def odd_mixer(h, w_in, c_qn, c_kn, c_sinks, d_mix, d_scale, w_out):
    B, L, _ = h.shape
    cq, ck, cv, dx = split_cols(h @ w_in, ODD_SIZES)
    hd = lambda t, n: t.reshape(B, L, n, -1)
    cq = rms_norm(hd(cq, C_HEADS), c_qn)
    ck = rms_norm(hd(ck, C_KV_HEADS), c_kn)
    yc = swa_sinks(pad_left(cq), pad_left(ck), pad_left(hd(cv, C_KV_HEADS)), c_sinks)
    yc = yc[:, META_PAD:].reshape(B, L, -1)
    yd = pool_mixer(dx, d_mix, d_scale)
    return jnp.concatenate([yc, yd], axis=-1) @ w_out


def setup_inputs(seed: int = 0) -> dict:
    key = jax.random.key(seed)
    ks = jax.random.split(key, 21)
    f32 = jnp.float32
    nrm = lambda k, shape, fan: jax.random.normal(k, shape, f32) * fan ** -0.5
    gain = lambda k, shape: 1.0 + 0.05 * jax.random.normal(k, shape, f32)
    return {
        "x": jax.random.normal(ks[0], (BATCH, SEQ, D_MODEL), f32),
        "meta_tokens": jax.random.normal(ks[1], (N_META, D_MODEL), f32),
        "ffn1_norm": gain(ks[2], (DEPTH, D_MODEL)),
        "ffn1_w_in": nrm(ks[3], (DEPTH, D_MODEL, 2 * D_FF), D_MODEL),
        "ffn1_w_out": nrm(ks[4], (DEPTH, D_FF, D_MODEL), D_FF),
        "mix_norm": gain(ks[5], (DEPTH, D_MODEL)),
        "ffn2_norm": gain(ks[6], (DEPTH, D_MODEL)),
        "ffn2_w_in": nrm(ks[7], (DEPTH, D_MODEL, 2 * D_FF), D_MODEL),
        "ffn2_w_out": nrm(ks[8], (DEPTH, D_FF, D_MODEL), D_FF),
        "ev_w_in": nrm(ks[9], (N_EVEN, D_MODEL, EVEN_IN), D_MODEL),
        "ev_a_q_norm": gain(ks[10], (N_EVEN, HEAD_DIM)),
        "ev_a_k_norm": gain(ks[11], (N_EVEN, HEAD_DIM)),
        "ev_w_out": nrm(ks[12], (N_EVEN, EVEN_OUT, D_MODEL), EVEN_OUT),
        "od_w_in": nrm(ks[13], (N_ODD, D_MODEL, ODD_IN), D_MODEL),
        "od_c_q_norm": gain(ks[14], (N_ODD, HEAD_DIM)),
        "od_c_k_norm": gain(ks[15], (N_ODD, HEAD_DIM)),
        "od_c_sinks": 0.5 * jax.random.normal(ks[16], (N_ODD, C_HEADS), f32),
        "od_d_mix": nrm(ks[17], (N_ODD, len(POOL_WINDOWS), D_GROUP, D_GROUP), D_GROUP),
        "od_d_scale": gain(ks[18], (N_ODD, D_WIDTH)),
        "od_w_out": nrm(ks[19], (N_ODD, ODD_OUT, D_MODEL), ODD_OUT),
    }


def reference(x, meta_tokens, ffn1_norm, ffn1_w_in, ffn1_w_out, mix_norm, ffn2_norm,
              ffn2_w_in, ffn2_w_out, ev_w_in, ev_a_q_norm, ev_a_k_norm, ev_w_out,
              od_w_in, od_c_q_norm, od_c_k_norm, od_c_sinks, od_d_mix, od_d_scale,
              od_w_out):
    B, S, D = x.shape
    top_k = min(DSA_MAX_K, S // 4)
    h = jnp.concatenate([jnp.broadcast_to(meta_tokens.astype(x.dtype)[None], (B, N_META, D)), x],
                        axis=1)
    for layer in range(DEPTH):
        h = h + (0.5 * swiglu(rms_norm(h, ffn1_norm[layer]), ffn1_w_in[layer],
                              ffn1_w_out[layer])).astype(h.dtype)
        hn = rms_norm(h, mix_norm[layer])
        if layer % 2 == 0:
            e = layer // 2
            y = even_mixer(hn, ev_w_in[e], ev_a_q_norm[e], ev_a_k_norm[e], ev_w_out[e], top_k)
        else:
            o = layer // 2
            y = odd_mixer(hn, od_w_in[o], od_c_q_norm[o], od_c_k_norm[o], od_c_sinks[o],
                          od_d_mix[o], od_d_scale[o], od_w_out[o])
        h = h + y.astype(h.dtype)
        h = h + (0.5 * swiglu(rms_norm(h, ffn2_norm[layer]), ffn2_w_in[layer],
                              ffn2_w_out[layer])).astype(h.dtype)
    return h[:, N_META:]
```

```cpp
#include <hip/hip_runtime.h>
#include <hip/hip_cooperative_groups.h>
#include <stdint.h>
#include <stdio.h>
namespace cg = cooperative_groups;

typedef _Float16 hf;
typedef _Float16 h8 __attribute__((ext_vector_type(8)));
typedef _Float16 h4 __attribute__((ext_vector_type(4)));
typedef short s8 __attribute__((ext_vector_type(8)));
typedef short s4 __attribute__((ext_vector_type(4)));
typedef float f4 __attribute__((ext_vector_type(4)));

#define NB 8
#define LP 2112
#define TP 16896
#define DM 1024
#define DFF 2816
#define PLD 3712
#define P_AQ 0
#define P_SBG 512
#define P_AK 1536
#define P_IQ 2048
#define P_IK 2560
#define P_IW 2624
#define P_BQ 2688
#define P_BK 3200
#define P2LD 1664
#define P2_CQ 0
#define P2_YD 512
#define P2_CK 1024
#define P2_DX 1152
#define LOG2E 1.4426950408889634f
#define SMEM_BYTES 73728

#define W_FFN_IN ((size_t)5632 * 1024)
#define W_FFN_OUT ((size_t)1024 * 2816)
#define OFF_WFI(i) ((size_t)(i) * W_FFN_IN)
#define OFF_WFO(i) (4 * W_FFN_IN + (size_t)(i) * W_FFN_OUT)
#define OFF_WEI (4 * W_FFN_IN + 4 * W_FFN_OUT)
#define OFF_WEO (OFF_WEI + (size_t)5376 * 1024)
#define OFF_WOI (OFF_WEO + (size_t)1024 * 1536)
#define OFF_WOO (OFF_WOI + (size_t)1280 * 1024)
#define W_TOTAL (OFF_WOO + (size_t)1024 * 1024)
#define WS_H16 (W_TOTAL * 2)
#define WS_PART (WS_H16 + (size_t)TP * 1024 * 2)
#define WS_BKDT (WS_PART + (size_t)TP * 16 * 4)
#define WS_BIG (WS_BKDT + (size_t)TP * 512 * 2)
#define WS_BAR (WS_BIG + (size_t)TP * PLD * 2)
#define WS_SLOT (WS_BAR + 16384)
#define WS_END (WS_SLOT + 4096)
#define DO_AVT ((size_t)0)
#define DO_BVT ((size_t)TP * 512 * 2)
#define DO_MASK (DO_BVT + (size_t)TP * 1024 * 2)
#define DO_CVT (DO_MASK + (size_t)TP * 33 * 8)

__constant__ float ROT_INV[32] = {
    1.000000000e+00f, 7.498942018e-01f, 5.623413324e-01f, 4.216965139e-01f, 3.162277639e-01f, 2.371373922e-01f,
    1.778279394e-01f, 1.333521456e-01f, 1.000000015e-01f, 7.498941571e-02f, 5.623412877e-02f, 4.216964915e-02f,
    3.162277862e-02f, 2.371373586e-02f, 1.778279431e-02f, 1.333521493e-02f, 9.999999776e-03f, 7.498942316e-03f,
    5.623413250e-03f, 4.216964822e-03f, 3.162277862e-03f, 2.371373819e-03f, 1.778279431e-03f, 1.333521446e-03f,
    1.000000047e-03f, 7.498941850e-04f, 5.623413017e-04f, 4.216965463e-04f, 3.162277862e-04f, 2.371373848e-04f,
    1.778279402e-04f, 1.333521504e-04f};

struct Params {
    const float* x; const float* meta; const float* ffn1_norm; const float* ffn1_w_in; const float* ffn1_w_out;
    const float* mix_norm; const float* ffn2_norm; const float* ffn2_w_in; const float* ffn2_w_out;
    const float* ev_w_in; const float* ev_a_q_norm; const float* ev_a_k_norm; const float* ev_w_out;
    const float* od_w_in; const float* od_c_q_norm; const float* od_c_k_norm; const float* od_c_sinks;
    const float* od_d_mix; const float* od_d_scale; const float* od_w_out;
    float* out; char* ws;
};

struct Ctx {
    hf* W; hf* h16; float* part; hf* bkdT; hf* big;
    short* avT; hf* bvT; uint64_t* mask; short* cvT; float* out;
    int xcd, slot, nslots;
};

__device__ __forceinline__ int tid_() { int t = threadIdx.x; asm volatile("" : "+v"(t)); return t; }
__device__ __forceinline__ int bid_() { int b = blockIdx.x; asm volatile("" : "+s"(b)); return b; }
__device__ __forceinline__ int nblk_() { int b = gridDim.x; asm volatile("" : "+s"(b)); return b; }
__device__ __forceinline__ f4 mfma16(h8 a, h8 b, f4 c) { return __builtin_amdgcn_mfma_f32_16x16x32_f16(a, b, c, 0, 0, 0); }
__device__ __forceinline__ f4 mfma16b(s8 a, s8 b, f4 c) { return __builtin_amdgcn_mfma_f32_16x16x32_bf16(a, b, c, 0, 0, 0); }
__device__ __forceinline__ unsigned short f2bf(float f) {
    unsigned u = __float_as_uint(f);
    u += 0x7FFFu + ((u >> 16) & 1u);
    return (unsigned short)(u >> 16);
}
__device__ __forceinline__ float silu_f(float x) { return x * __builtin_amdgcn_rcpf(1.0f + __builtin_amdgcn_exp2f(-x * LOG2E)); }
__device__ __forceinline__ float row_rs(const float* part, int m) {
    const f4* p = (const f4*)(part + (size_t)m * 16);
    f4 a = p[0], b = p[1], c = p[2], d = p[3];
    float s = (((a[0] + a[1]) + (a[2] + a[3])) + ((b[0] + b[1]) + (b[2] + b[3]))) +
              (((c[0] + c[1]) + (c[2] + c[3])) + ((d[0] + d[1]) + (d[2] + d[3])));
    return rsqrtf(s * (1.0f / 1024.0f) + 1e-6f);
}
__device__ __forceinline__ float wave_maxabs64(const float* g, int lane) {
    float v = fabsf(g[lane]);
#pragma unroll
    for (int o = 32; o >= 1; o >>= 1) v = fmaxf(v, __shfl_xor(v, o));
    return v;
}
__device__ __forceinline__ h8 cat44(h4 a, h4 b) {
    h8 r; r[0] = a[0]; r[1] = a[1]; r[2] = a[2]; r[3] = a[3]; r[4] = b[0]; r[5] = b[1]; r[6] = b[2]; r[7] = b[3]; return r;
}
__device__ __forceinline__ s8 cat44s(s4 a, s4 b) {
    s8 r; r[0] = a[0]; r[1] = a[1]; r[2] = a[2]; r[3] = a[3]; r[4] = b[0]; r[5] = b[1]; r[6] = b[2]; r[7] = b[3]; return r;
}


#define XB_TMO      128
#define XB_XCNT(j)  (256  + 64 * (j))
#define XB_XSUB(j)  (1280 + 64 * (j))
#define XB_XGEN(j)  (2304 + 64 * (j))
#define XB_TOP      3328
#define XB_TOPGEN   3392
#define XCD_BAR_WORDS 3456
#define XB_SPIN_CAP (1u << 18)
#define LAS __attribute__((address_space(3)))
__device__ __forceinline__ unsigned xb_ld(unsigned* p)              { return __hip_atomic_load(p, __ATOMIC_RELAXED, __HIP_MEMORY_SCOPE_AGENT); }
__device__ __forceinline__ unsigned xb_add(unsigned* p, unsigned v) { return __hip_atomic_fetch_add(p, v, __ATOMIC_RELAXED, __HIP_MEMORY_SCOPE_AGENT); }
__device__ __forceinline__ unsigned xb_xcc_id() { return (unsigned)__builtin_amdgcn_s_getreg((3 << 11) | 20) & 0xFu; }
#define XB_SPIN(cond, bar) do { unsigned _sp = 0; while (cond) { __builtin_amdgcn_s_sleep(1); \
    if ((++_sp & 255u) == 0u) { if (xb_ld(&(bar)[XB_TMO])) break; if (_sp > XB_SPIN_CAP) { atomicAdd(&(bar)[XB_TMO], 1u); break; } } } } while (0)
struct XcdBarrier { unsigned* bar; unsigned x; volatile LAS unsigned* st; };
__device__ __forceinline__ XcdBarrier xcd_barrier_post(unsigned* bar, volatile LAS unsigned* st) {
    XcdBarrier b; b.bar = bar; b.x = xb_xcc_id(); b.st = st;
    if (threadIdx.x == 0) (void)xb_add(&bar[XB_XCNT(b.x)], 1u);
    return b;
}
__device__ __forceinline__ void xcd_barrier_complete(unsigned* bar, unsigned x, unsigned& nloc, unsigned& nx) {
    const unsigned G = gridDim.x * gridDim.y * gridDim.z;
    unsigned sum, cnt, mine, sp = 0u;
    for (;;) {
        sum = 0u; cnt = 0u; mine = 0u;
#pragma unroll
        for (unsigned j = 0; j < 16; ++j) { const unsigned c = xb_ld(&bar[XB_XCNT(j)]); sum += c; cnt += (c > 0u) ? 1u : 0u; mine = (j == x) ? c : mine; }
        if (sum == G) break;
        __builtin_amdgcn_s_sleep(1);
        if ((++sp & 255u) == 0u) { if (xb_ld(&bar[XB_TMO])) break; if (sp > XB_SPIN_CAP) { atomicAdd(&bar[XB_TMO], 1u); break; } }
    }
    nloc = mine > 0u ? mine : 1u; nx = cnt > 0u ? cnt : 1u;
}
__device__ __forceinline__ void xcd_barrier(const XcdBarrier& b) {
    asm volatile("s_waitcnt vmcnt(0)" ::: "memory");
    __syncthreads();
    if (threadIdx.x == 0) {
        unsigned* bar = b.bar;
        __builtin_amdgcn_s_waitcnt(0);
        unsigned nloc = b.st[0], nx = b.st[1];
        if (nloc == 0u) { xcd_barrier_complete(bar, b.x, nloc, nx); b.st[0] = nloc; b.st[1] = nx; }
        const unsigned old = xb_add(&bar[XB_XSUB(b.x)], 1u);
        const unsigned gen = old / nloc;
        if (old + 1u == (gen + 1u) * nloc) {
            __builtin_amdgcn_fence(__ATOMIC_RELEASE, "agent");
            asm volatile("s_waitcnt vmcnt(0)" ::: "memory");
            const unsigned og = xb_add(&bar[XB_TOP], 1u);
            const unsigned tg = og / nx;
            if (og + 1u == (tg + 1u) * nx) xb_add(&bar[XB_TOPGEN], 1u);
            else XB_SPIN(xb_ld(&bar[XB_TOPGEN]) == tg, bar);
            __builtin_amdgcn_fence(__ATOMIC_ACQUIRE, "agent");
            xb_add(&bar[XB_XGEN(b.x)], 1u);
            asm volatile("s_waitcnt vmcnt(0)" ::: "memory");
        } else {
            XB_SPIN(xb_ld(&bar[XB_XGEN(b.x)]) == gen, bar);
            __builtin_amdgcn_fence(__ATOMIC_ACQUIRE, "agent");
            asm volatile("s_waitcnt vmcnt(0)" ::: "memory");
        }
    }
    __syncthreads();
}

__device__ __forceinline__ void xcd_barrier_arrive(const XcdBarrier& b) {
    asm volatile("s_waitcnt vmcnt(0)" ::: "memory");
    __syncthreads();
    if (threadIdx.x == 0) {
        unsigned* bar = b.bar;
        __builtin_amdgcn_s_waitcnt(0);
        unsigned nloc = b.st[0], nx = b.st[1];
        if (nloc == 0u) { xcd_barrier_complete(bar, b.x, nloc, nx); b.st[0] = nloc; b.st[1] = nx; }
        const unsigned old = xb_add(&bar[XB_XSUB(b.x)], 1u);
        const unsigned gen = old / nloc;
        if (old + 1u == (gen + 1u) * nloc) {
            __builtin_amdgcn_fence(__ATOMIC_RELEASE, "agent");
            asm volatile("s_waitcnt vmcnt(0)" ::: "memory");
            const unsigned og = xb_add(&bar[XB_TOP], 1u);
            const unsigned tg = og / nx;
            if (og + 1u == (tg + 1u) * nx) xb_add(&bar[XB_TOPGEN], 1u);
            else XB_SPIN(xb_ld(&bar[XB_TOPGEN]) == tg, bar);
            __builtin_amdgcn_fence(__ATOMIC_ACQUIRE, "agent");
            xb_add(&bar[XB_XGEN(b.x)], 1u);
            asm volatile("s_waitcnt vmcnt(0)" ::: "memory");
            b.st[3] = 0xFFFFFFFFu;
        } else {
            b.st[3] = gen;
        }
    }
    __syncthreads();
}
__device__ __forceinline__ void xcd_barrier_wait(const XcdBarrier& b) {
    __syncthreads();
    if (threadIdx.x == 0) {
        unsigned* bar = b.bar;
        const unsigned gen = b.st[3];
        if (gen != 0xFFFFFFFFu) { XB_SPIN(xb_ld(&bar[XB_XGEN(b.x)]) == gen, bar); }
        __builtin_amdgcn_fence(__ATOMIC_ACQUIRE, "agent");
        asm volatile("s_waitcnt vmcnt(0)" ::: "memory");
    }
    __syncthreads();
}

__device__ __forceinline__ int map_perm32(int n) { return (n & ~31) + (((n & 15) >> 2) * 8) + (((n >> 4) & 1) * 4) + (n & 3); }
__device__ __forceinline__ int map_col(int maptype, int n) {
    if (maptype == 1) {
        const int B = n >> 6, j = (n >> 4) & 3, rho = n & 15;
        return (j & 1) * DFF + B * 32 + (rho >> 2) * 8 + (j >> 1) * 4 + (rho & 3);
    }
    n = map_perm32(n);
    if (maptype == 0) return n;
    if (n < 2112) return n;
    if (n < 2176) { int o = n - 2112; return o < 8 ? 2112 + o : -1; }
    if (n >= 5248) return -1;
    return n - 56;
}
__device__ __forceinline__ void convert_job(const float* __restrict__ src, int ldsrc, int K, int Ndst, int maptype, const float* __restrict__ gain,
                            hf* __restrict__ dst, int lddst, char* smem) {
    float* tile = (float*)smem;
    const int tid = tid_();
    const int nkt = K >> 6, nnt = Ndst >> 6;
    for (int t = bid_(); t < nkt * nnt; t += nblk_()) {
        const int kt = t % nkt, ntile = t / nkt;
        const int k0 = kt * 64, n0 = ntile * 64;
        {
            const int nq = (tid & 15) * 4;
            const int sc = map_col(maptype, n0 + nq);
#pragma unroll
            for (int i = 0; i < 4; ++i) {
                const int k = i * 16 + (tid >> 4);
                f4 v = {0.f, 0.f, 0.f, 0.f};
                if (sc >= 0) v = *(const f4*)(src + (size_t)(k0 + k) * ldsrc + sc);
                if (gain) v = v * gain[k0 + k];
                *(f4*)(tile + k * 68 + (nq ^ ((k >> 3) << 2))) = v;
            }
        }
        __syncthreads();
        {
#pragma unroll
            for (int i = 0; i < 2; ++i) {
                const int q = tid + 256 * i;
                const int n = q >> 3, kg = (q & 7) * 8;
                h8 o;
#pragma unroll
                for (int e = 0; e < 8; ++e) o[e] = (hf)tile[(kg + e) * 68 + (n ^ ((kg >> 3) << 2))];
                *(h8*)(dst + (size_t)(n0 + n) * lddst + k0 + kg) = o;
            }
        }
        __syncthreads();
    }
}

__device__ __forceinline__ void prologue(const Params& p, const Ctx& c, char* smem) {
    const int tid = tid_(), lane = tid & 63, w = tid >> 6;
    for (int l = 0; l < 2; ++l) {
        convert_job(p.ffn1_w_in + (size_t)l * 1024 * 5632, 5632, 1024, 5632, 1, p.ffn1_norm + l * 1024, c.W + OFF_WFI(l * 2 + 0), 1024, smem);
        convert_job(p.ffn2_w_in + (size_t)l * 1024 * 5632, 5632, 1024, 5632, 1, p.ffn2_norm + l * 1024, c.W + OFF_WFI(l * 2 + 1), 1024, smem);
        convert_job(p.ffn1_w_out + (size_t)l * 2816 * 1024, 1024, 2816, 1024, 0, nullptr, c.W + OFF_WFO(l * 2 + 0), 2816, smem);
        convert_job(p.ffn2_w_out + (size_t)l * 2816 * 1024, 1024, 2816, 1024, 0, nullptr, c.W + OFF_WFO(l * 2 + 1), 2816, smem);
    }
    convert_job(p.ev_w_in, 5192, 1024, 5376, 2, p.mix_norm, c.W + OFF_WEI, 1024, smem);
    convert_job(p.ev_w_out, 1024, 1536, 1024, 0, nullptr, c.W + OFF_WEO, 1536, smem);
    convert_job(p.od_w_in, 1280, 1024, 1280, 0, p.mix_norm + 1024, c.W + OFF_WOI, 1024, smem);
    convert_job(p.od_w_out, 1024, 512, 1024, 0, nullptr, c.W + OFF_WOO, 1024, smem);
    for (int it = bid_(); it < 256; it += nblk_()) {
        const int n4 = it * 4;
#pragma unroll 1
        for (int kk = 0; kk < 2; ++kk) {
            const int kp = tid + kk * 256;
            const int g = kp >> 7, i = kp & 127;
            const float* dm = p.od_d_mix + ((size_t)g * 128 + i) * 128;
            const float* ds = p.od_d_scale + g * 128;
            const float* wo = p.od_w_out + (size_t)(512 + g * 128) * 1024 + n4;
            float a0 = 0.f, a1 = 0.f, a2 = 0.f, a3 = 0.f;
#pragma unroll 4
            for (int j = 0; j < 128; ++j) {
                const float m = dm[j] * ds[j];
                const f4 wv = *(const f4*)(wo + (size_t)j * 1024);
                a0 += m * wv[0]; a1 += m * wv[1]; a2 += m * wv[2]; a3 += m * wv[3];
            }
            const int nrow = (n4 & ~31) + (((n4 >> 2) & 1) * 16) + (((n4 & 31) >> 3) * 4);
            hf* d = c.W + OFF_WOO + (size_t)nrow * 1024 + 512 + kp;
            d[0] = (hf)a0; d[1024] = (hf)a1; d[2048] = (hf)a2; d[3072] = (hf)a3;
        }
    }
    for (int it = bid_(); it < TP / 4; it += nblk_()) {
        const int row = it * 4 + w;
        const int b = row / LP, pp = row - b * LP;
        const float* src = nullptr;
        if (pp >= 64) src = p.x + ((size_t)b * 2048 + (pp - 64)) * 1024;
        else if (pp >= 48) src = p.meta + (size_t)(pp - 48) * 1024;
        float ss = 0.f;
        hf* d = c.h16 + (size_t)row * 1024;
#pragma unroll
        for (int k = 0; k < 2; ++k) {
            const int col = k * 512 + lane * 8;
            f4 v0 = {0.f, 0.f, 0.f, 0.f}, v1 = {0.f, 0.f, 0.f, 0.f};
            if (src) { v0 = *(const f4*)(src + col); v1 = *(const f4*)(src + col + 4); }
            h8 o;
#pragma unroll
            for (int r = 0; r < 4; ++r) {
                o[r] = (hf)v0[r]; o[4 + r] = (hf)v1[r];
                const float q0 = (float)o[r], q1 = (float)o[4 + r];
                ss += q0 * q0 + q1 * q1;
            }
            *(h8*)(d + col) = o;
        }
#pragma unroll
        for (int o = 32; o >= 1; o >>= 1) ss += __shfl_xor(ss, o);
        if (lane < 16) c.part[(size_t)row * 16 + lane] = (lane == 0) ? ss : 0.f;
    }
}

__device__ __forceinline__ unsigned dpp_qx1(unsigned v) { return (unsigned)__builtin_amdgcn_update_dpp(0, (int)v, 0xB1, 0xF, 0xF, true); }
__device__ __forceinline__ unsigned dpp_qx2(unsigned v) { return (unsigned)__builtin_amdgcn_update_dpp(0, (int)v, 0x4E, 0xF, 0xF, true); }
__device__ __forceinline__ void quad_transpose(unsigned (&v)[4], int t) {
    {
        const unsigned s0 = (t & 1) ? v[0] : v[1], r0 = dpp_qx1(s0);
        const unsigned s1 = (t & 1) ? v[2] : v[3], r1 = dpp_qx1(s1);
        if (t & 1) { v[0] = r0; v[2] = r1; } else { v[1] = r0; v[3] = r1; }
    }
    {
        const unsigned s0 = (t & 2) ? v[0] : v[2], r0 = dpp_qx2(s0);
        const unsigned s1 = (t & 2) ? v[1] : v[3], r1 = dpp_qx2(s1);
        if (t & 2) { v[0] = r0; v[1] = r1; } else { v[2] = r0; v[3] = r1; }
    }
}
__device__ __forceinline__ unsigned hbits(float x) { const hf h = (hf)x; return (unsigned)__builtin_bit_cast(unsigned short, h); }
__device__ __forceinline__ void store_tr4(unsigned short* base  , int rowoff, int l15, unsigned (&u)[4]) {
    const int t = l15 & 3;
    quad_transpose(u, t);
    uint2 pk; pk.x = u[0] | (u[1] << 16); pk.y = u[2] | (u[3] << 16);
    *(uint2*)(base + (size_t)(rowoff + t) * LP - t) = pk;
}

#define COLO(j) ((((j) >> 1) * 32) + lg * 8 + (((j) & 1) * 4))
enum { EPI_SWIGLU = 0, EPI_RESID = 1, EPI_FINAL = 2, EPI_EVEN = 3, EPI_ODD = 4 };

template <int BM>
__device__ __forceinline__ bool gemm_item(const Ctx& c, int it, int NT, int& mt, int& nt) {
    const int x = c.xcd, slot = c.slot, nslots = c.nslots;
    const int MTT = TP / BM;
    const int base = MTT / 8, rem = MTT % 8;
    const int mb = base + (x < rem ? 1 : 0);
    const int mstart = x * base + (x < rem ? x : rem);
    const int li = it * nslots + slot;
    if (li >= mb * NT) return false;
    const int per_g = 8 * NT;
    const int g = li / per_g, r = li - g * per_g;
    int gsz = mb - g * 8; gsz = gsz > 8 ? 8 : gsz;
    nt = r / gsz;
    mt = mstart + g * 8 + (r - nt * gsz);
    return true;
}

template <int EPI, int MI>
__device__ __forceinline__ void gemm_epilogue(f4 (&acc)[MI][4], float rsl, int m0, int n0, int nt, const Ctx& c, float ep_scale, const float* ep_g1, const float* ep_g2, int wm, int wn, int l15, int lg) {
    if constexpr (EPI == EPI_SWIGLU) {
        hf* act = c.big;
#pragma unroll
        for (int i = 0; i < MI; ++i) {
            const int m = m0 + wm * (MI * 16) + i * 16 + l15;
            const float rs = __shfl(rsl, i * 16 + l15);
            h8 o;
#pragma unroll
            for (int jp = 0; jp < 2; ++jp)
#pragma unroll
                for (int r = 0; r < 4; ++r) {
                    const float g = acc[i][2 * jp][r] * rs, u = acc[i][2 * jp + 1][r] * rs;
                    o[jp * 4 + r] = (hf)(silu_f(g) * u);
                }
            *(h8*)(act + (size_t)m * DFF + (n0 >> 1) + wn * 32 + lg * 8) = o;
        }
    } else if constexpr (EPI == EPI_RESID || EPI == EPI_FINAL) {
#pragma unroll
        for (int i = 0; i < MI; ++i) {
            const int m = m0 + wm * (MI * 16) + i * 16 + l15;
            const int b = m / LP, pp = m - b * LP;
            const bool pad = pp < 48;
            float ss = 0.f;
#pragma unroll
            for (int jp = 0; jp < 2; ++jp) {
                const int col = n0 + wn * 64 + jp * 32 + lg * 8;
                hf* hp = c.h16 + (size_t)m * 1024 + col;
                const h8 old = *(const h8*)hp;
                f4 v0, v1;
#pragma unroll
                for (int r = 0; r < 4; ++r) {
                    v0[r] = (float)old[r] + (pad ? 0.f : ep_scale * acc[i][2 * jp][r]);
                    v1[r] = (float)old[4 + r] + (pad ? 0.f : ep_scale * acc[i][2 * jp + 1][r]);
                }
                if constexpr (EPI == EPI_FINAL) {
                    if (pp >= 64) {
                        float* op = c.out + ((size_t)b * 2048 + (pp - 64)) * 1024 + col;
                        *(f4*)op = v0; *(f4*)(op + 4) = v1;
                    }
                } else {
                    h8 nw;
#pragma unroll
                    for (int r = 0; r < 4; ++r) {
                        nw[r] = (hf)v0[r]; nw[4 + r] = (hf)v1[r];
                        const float q0 = (float)nw[r], q1 = (float)nw[4 + r];
                        ss += q0 * q0 + q1 * q1;
                    }
                    *(h8*)hp = nw;
                }
                __builtin_amdgcn_sched_barrier(0);
            }
            if constexpr (EPI == EPI_RESID) {
                ss += __shfl_xor(ss, 16); ss += __shfl_xor(ss, 32);
                if (lg == 0) c.part[(size_t)m * 16 + nt * 2 + wn] = ss;
            }
        }
    } else if constexpr (EPI == EPI_EVEN) {
        hf* P = c.big;
        const int g = (n0 >> 6) + wn;
        if (g >= 82) return;
        int type, hidx = 0, coff = 0;
        if (g < 8) { type = 0; hidx = g; coff = P_AQ + g * 64; }
        else if (g < 16) { type = 1; hidx = g - 8; coff = P_AK + (g - 8) * 64; }
        else if (g < 24) { type = 2; hidx = g - 16; }
        else if (g < 32) { type = 3; coff = P_IQ + (g - 24) * 64; }
        else if (g == 32) { type = 3; coff = P_IK; }
        else if (g == 33) { type = 3; coff = P_IW; }
        else if (g < 42) { type = 4; hidx = g - 34; coff = P_BQ + (g - 34) * 64; }
        else if (g < 50) { type = 5; hidx = g - 42; coff = P_BK + (g - 42) * 64; }
        else if (g < 66) { type = 6; hidx = g - 50; }
        else { type = 7; coff = P_SBG + (g - 66) * 64; }
        float l2g = 0.f;
        if (type == 5) l2g = __log2f(1.0f - exp2f(-5.0f - (float)hidx));
#pragma unroll
        for (int i = 0; i < MI; ++i) {
            const int m = m0 + wm * (MI * 16) + i * 16 + l15;
            const int b = m / LP, pp = m - b * LP;
            const float rs = __shfl(rsl, i * 16 + l15);
            f4 v[4];
#pragma unroll
            for (int j = 0; j < 4; ++j) v[j] = acc[i][j] * rs;
            if (type == 0 || type == 1) {
                float ss = 0.f;
#pragma unroll
                for (int j = 0; j < 4; ++j)
#pragma unroll
                    for (int r = 0; r < 4; ++r) ss += v[j][r] * v[j][r];
                ss += __shfl_xor(ss, 16); ss += __shfl_xor(ss, 32);
                const float hr = rsqrtf(ss * (1.0f / 64.0f) + 1e-6f) * (type == 0 ? 0.125f : 1.0f);
                const float* gn = (type == 0) ? ep_g1 : ep_g2;
#pragma unroll
                for (int j = 0; j < 4; ++j) {
                    const f4 gv = *(const f4*)(gn + COLO(j));
                    v[j] = v[j] * hr * gv;
                }
            } else if (type == 4 || type == 5) {
                const float pos = (float)(pp - 48);
#pragma unroll
                for (int j = 0; j < 2; ++j)
#pragma unroll
                    for (int r = 0; r < 4; ++r) {
                        const float ang = pos * ROT_INV[COLO(j) + r];
                        const float rv = ang * 0.15915494f;
                        const float er = fmaf(ang, 0.15915494f, -rv) + ang * 1.4069382e-9f;
                        const float fr = (rv - floorf(rv)) + er;
                        const float sn = __builtin_amdgcn_sinf(fr), cs = __builtin_amdgcn_cosf(fr);
                        const float x1 = v[j][r], x2 = v[j + 2][r];
                        v[j][r] = x1 * cs - x2 * sn;
                        v[j + 2][r] = x1 * sn + x2 * cs;
                    }
                if (type == 5) {
#pragma unroll
                    for (int j = 0; j < 4; ++j) v[j] = v[j] * 0.125f;
                    const float dec = exp2f((float)(63 - (pp & 63)) * l2g);
                    unsigned short* kd = (unsigned short*)(c.bkdT + ((size_t)(b * 8 + hidx) * 64) * LP + pp);
#pragma unroll
                    for (int j = 0; j < 4; ++j) {
                        unsigned u[4];
#pragma unroll
                        for (int r = 0; r < 4; ++r) u[r] = hbits(v[j][r] * dec);
                        store_tr4(kd, COLO(j), l15, u);
                    }
                }
            } else if (type == 7) {
#pragma unroll
                for (int j = 0; j < 4; ++j)
#pragma unroll
                    for (int r = 0; r < 4; ++r) v[j][r] = silu_f(v[j][r]);
            }
            if (type == 2) {
                unsigned short* d = (unsigned short*)(c.avT + ((size_t)(b * 8 + hidx) * 64) * LP + pp);
#pragma unroll
                for (int j = 0; j < 4; ++j) {
                    unsigned u[4];
#pragma unroll
                    for (int r = 0; r < 4; ++r) u[r] = f2bf(v[j][r]);
                    store_tr4(d, COLO(j), l15, u);
                }
            } else if (type == 6) {
                unsigned short* d = (unsigned short*)(c.bvT + ((size_t)(b * 8 + (hidx >> 1)) * 128 + (hidx & 1) * 64) * LP + pp);
#pragma unroll
                for (int j = 0; j < 4; ++j) {
                    unsigned u[4];
#pragma unroll
                    for (int r = 0; r < 4; ++r) u[r] = hbits(v[j][r]);
                    store_tr4(d, COLO(j), l15, u);
                }
            } else {
#pragma unroll
                for (int jp = 0; jp < 2; ++jp) {
                    h8 o;
#pragma unroll
                    for (int r = 0; r < 4; ++r) { o[r] = (hf)v[2 * jp][r]; o[4 + r] = (hf)v[2 * jp + 1][r]; }
                    *(h8*)(P + (size_t)m * PLD + coff + jp * 32 + lg * 8) = o;
                }
            }
        }
    } else {
        hf* P2 = c.big;
        const int g = (n0 >> 6) + wn;
        int type, hidx = 0, coff = 0;
        if (g < 8) { type = 0; coff = P2_CQ + g * 64; }
        else if (g < 10) { type = 1; coff = P2_CK + (g - 8) * 64; }
        else if (g < 12) { type = 2; hidx = g - 10; }
        else { type = 3; coff = P2_DX + (g - 12) * 64; }
#pragma unroll
        for (int i = 0; i < MI; ++i) {
            const int m = m0 + wm * (MI * 16) + i * 16 + l15;
            const int b = m / LP, pp = m - b * LP;
            const float rs = __shfl(rsl, i * 16 + l15);
            f4 v[4];
#pragma unroll
            for (int j = 0; j < 4; ++j) v[j] = acc[i][j] * rs;
            if (type == 0 || type == 1) {
                float ss = 0.f;
#pragma unroll
                for (int j = 0; j < 4; ++j)
#pragma unroll
                    for (int r = 0; r < 4; ++r) ss += v[j][r] * v[j][r];
                ss += __shfl_xor(ss, 16); ss += __shfl_xor(ss, 32);
                const float hr = rsqrtf(ss * (1.0f / 64.0f) + 1e-6f) * (type == 0 ? 0.125f : 1.0f);
                const float* gn = (type == 0) ? ep_g1 : ep_g2;
#pragma unroll
                for (int j = 0; j < 4; ++j) {
                    const f4 gv = *(const f4*)(gn + COLO(j));
                    v[j] = v[j] * hr * gv;
                }
            }
            if (type == 2) {
                unsigned short* d = (unsigned short*)(c.cvT + ((size_t)(b * 2 + hidx) * 64) * LP + pp);
#pragma unroll
                for (int j = 0; j < 4; ++j) {
                    unsigned u[4];
#pragma unroll
                    for (int r = 0; r < 4; ++r) u[r] = f2bf(v[j][r]);
                    store_tr4(d, COLO(j), l15, u);
                }
            } else {
#pragma unroll
                for (int jp = 0; jp < 2; ++jp) {
                    h8 o;
#pragma unroll
                    for (int r = 0; r < 4; ++r) { o[r] = (hf)v[2 * jp][r]; o[4 + r] = (hf)v[2 * jp + 1][r]; }
                    *(h8*)(P2 + (size_t)m * P2LD + coff + jp * 32 + lg * 8) = o;
                }
            }
        }
    }
}

template <int EPI, int MI>
__device__ __forceinline__ void gemm_phase(const hf* __restrict__ A, int lda, const hf* __restrict__ Bt, int N, int K, const Ctx& c, float ep_scale, const float* ep_g1, const float* ep_g2, char* smem) {
    constexpr int BM = MI * 32;
    const int tid = tid_(), lane = tid & 63, w = tid >> 6, wm = w >> 1, wn = w & 1, l15 = lane & 15, lg = lane >> 4;
    hf* As = (hf*)smem;
    hf* Bs = As + 2 * 128 * 64;
    const int NT = N >> 7, nk = K >> 6;
    const int lrow = tid >> 3, lcol = (tid & 7) * 8;
    const int gcol = ((tid & 7) ^ ((lrow >> 1) & 7)) * 8;
    const int rc0 = (lg ^ (l15 >> 1)) * 8, rc1 = ((4 + lg) ^ (l15 >> 1)) * 8;
    int mt, nt;
    bool have = gemm_item<BM>(c, 0, NT, mt, nt);
    if (!have) return;
    const hf* Ap = A + (size_t)(mt * BM + lrow) * lda + gcol;
    const hf* Bp = Bt + (size_t)(nt * 128 + lrow) * K + gcol;
    hf* const adst = As + lrow * 64 + lcol;
    hf* const bdst = Bs + lrow * 64 + lcol;
#define GEMM_DMA(LA, LB, STAGE)                                                                                               \
    {                                                                                                                         \
        _Pragma("unroll") for (int i = 0; i < MI; ++i)                                                                        \
            __builtin_amdgcn_global_load_lds((const unsigned*)((LA) + (size_t)(32 * i) * lda),                                \
                                             (unsigned*)(adst + (STAGE) * (128 * 64) + (32 * i) * 64), 16, 0, 0);             \
        _Pragma("unroll") for (int i = 0; i < 4; ++i)                                                                         \
            __builtin_amdgcn_global_load_lds((const unsigned*)((LB) + (size_t)(32 * i) * K),                                  \
                                             (unsigned*)(bdst + (STAGE) * (128 * 64) + (32 * i) * 64), 16, 0, 0);             \
    }
    GEMM_DMA(Ap, Bp, 0)
    __syncthreads();
    for (int it = 0; have; ++it) {
        int mtn, ntn;
        const bool haven = gemm_item<BM>(c, it + 1, NT, mtn, ntn);
        const hf* Apn = haven ? A + (size_t)(mtn * BM + lrow) * lda + gcol : Ap;
        const hf* Bpn = haven ? Bt + (size_t)(ntn * 128 + lrow) * K + gcol : Bp;
        f4 acc[MI][4];
#pragma unroll
        for (int i = 0; i < MI; ++i)
#pragma unroll
            for (int j = 0; j < 4; ++j) acc[i][j] = (f4){0.f, 0.f, 0.f, 0.f};
        f4 pr0, pr1, pr2, pr3;
        float rsl = 0.f;
        constexpr bool NEED_RS = (EPI == EPI_SWIGLU || EPI == EPI_EVEN || EPI == EPI_ODD);
        if constexpr (NEED_RS) {
            const int rl = lane < MI * 16 ? lane : MI * 16 - 1;
            const f4* pp = (const f4*)(c.part + (size_t)(mt * BM + wm * (MI * 16) + rl) * 16);
            pr0 = pp[0]; pr1 = pp[1]; pr2 = pp[2]; pr3 = pp[3];
        }
        for (int ks = 0; ks < nk; ks += 2) {
            if constexpr (NEED_RS) {
                if (ks == 2) {
                    const float sm = (((pr0[0] + pr0[1]) + (pr0[2] + pr0[3])) + ((pr1[0] + pr1[1]) + (pr1[2] + pr1[3]))) +
                                     (((pr2[0] + pr2[1]) + (pr2[2] + pr2[3])) + ((pr3[0] + pr3[1]) + (pr3[2] + pr3[3])));
                    rsl = rsqrtf(sm * (1.0f / 1024.0f) + 1e-6f);
                }
            }
            const bool tail = (ks + 2 >= nk);
            const hf* la1 = Ap + (ks + 1) * 64;
            const hf* lb1 = Bp + (ks + 1) * 64;
            const hf* la2 = tail ? Apn : Ap + (ks + 2) * 64;
            const hf* lb2 = tail ? Bpn : Bp + (ks + 2) * 64;
#pragma unroll
            for (int half = 0; half < 2; ++half) {
                const hf* as = As + half * (128 * 64) + (wm * (MI * 16) + l15) * 64;
                const hf* bs = Bs + half * (128 * 64) + (wn * 64 + l15) * 64;
                h8 af[2][MI], bf[2][4];
#pragma unroll
                for (int kk = 0; kk < 2; ++kk) {
#pragma unroll
                    for (int i = 0; i < MI; ++i) af[kk][i] = *(const h8*)(as + i * 16 * 64 + (kk ? rc1 : rc0));
#pragma unroll
                    for (int i = 0; i < 4; ++i) bf[kk][i] = *(const h8*)(bs + i * 16 * 64 + (kk ? rc1 : rc0));
                }
                __builtin_amdgcn_sched_barrier(0);
                __builtin_amdgcn_s_setprio(1);
#pragma unroll
                for (int i = 0; i < MI; ++i)
#pragma unroll
                    for (int j = 0; j < 4; ++j) acc[i][j] = mfma16(bf[0][j], af[0][i], acc[i][j]);
                __builtin_amdgcn_s_setprio(0);
                __builtin_amdgcn_sched_barrier(0);
                if (half == 0) GEMM_DMA(la1, lb1, 1)
                else GEMM_DMA(la2, lb2, 0)
                __builtin_amdgcn_sched_barrier(0);
                __builtin_amdgcn_s_setprio(1);
#pragma unroll
                for (int i = 0; i < MI; ++i)
#pragma unroll
                    for (int j = 0; j < 4; ++j) acc[i][j] = mfma16(bf[1][j], af[1][i], acc[i][j]);
                __builtin_amdgcn_s_setprio(0);
                __syncthreads();
            }
        }
        gemm_epilogue<EPI, MI>(acc, rsl, mt * BM, nt * 128, nt, c, ep_scale, ep_g1, ep_g2, wm, wn, l15, lg);
        mt = mtn; nt = ntn; Ap = Apn; Bp = Bpn; have = haven;
    }
#undef GEMM_DMA
}

template <int EPI>
__device__ __forceinline__ void gemm_wide(const hf* __restrict__ A, int lda, const hf* __restrict__ Bt, int N, int K, const Ctx& c, float ep_scale, const float* ep_g1, const float* ep_g2, char* smem) {
    const int tid = tid_(), lane = tid & 63, w = tid >> 6, wm = w >> 1, wn = w & 1, l15 = lane & 15, lg = lane >> 4;
    const int NT = N >> 8, nk = K >> 5;
    const int rloc = lane >> 2;
    const int fsw_d = (0x1320 >> (((rloc >> 2) & 3) * 4)) & 3;
    const int gchunk = ((lane & 3) ^ fsw_d) * 8;
    const int fsw_r = (0x1320 >> (((l15 >> 2) & 3) * 4)) & 3;
    const int rpos = (lg ^ fsw_r) * 16;
    char* const ldsb = smem;
    const int dst0 = tid * 16;
    int mt, nt;
    bool have = gemm_item<128>(c, 0, NT, mt, nt);
    if (!have) return;
    const int aoff = (16 * w + rloc) * lda + gchunk, boff = (16 * w + rloc) * K + gchunk;
    const hf* Ap = A + (size_t)(mt * 128) * lda;
    const hf* Bp = Bt + (size_t)(nt * 256) * K;
#define WIDE_DMA(LA, LB, STAGE)                                                                                            \
    {                                                                                                                      \
        char* sb_ = ldsb + (STAGE) * 24576 + dst0;                                                                         \
        _Pragma("unroll") for (int i = 0; i < 2; ++i)                                                                      \
            __builtin_amdgcn_global_load_lds((const unsigned*)(((LA) + (size_t)(64 * i) * lda) + aoff), (unsigned*)(sb_ + i * 4096), 16, 0, 0);          \
        _Pragma("unroll") for (int i = 0; i < 4; ++i)                                                                      \
            __builtin_amdgcn_global_load_lds((const unsigned*)(((LB) + (size_t)(64 * i) * K) + boff), (unsigned*)(sb_ + 8192 + i * 4096), 16, 0, 0);      \
    }
    WIDE_DMA(Ap, Bp, 0)
    WIDE_DMA(Ap + 32, Bp + 32, 1)
    asm volatile("s_waitcnt vmcnt(6)" ::: "memory");
    __builtin_amdgcn_s_barrier();
    asm volatile("" ::: "memory");
    int st = 0;
    for (int it = 0; have; ++it) {
        int mtn, ntn;
        const bool haven = gemm_item<128>(c, it + 1, NT, mtn, ntn);
        const hf* Apn = haven ? A + (size_t)(mtn * 128) * lda : Ap;
        const hf* Bpn = haven ? Bt + (size_t)(ntn * 256) * K : Bp;
        f4 acc0[4][4], acc1[4][4];
#pragma unroll
        for (int i = 0; i < 4; ++i)
#pragma unroll
            for (int j = 0; j < 4; ++j) { acc0[i][j] = (f4){0.f, 0.f, 0.f, 0.f}; acc1[i][j] = (f4){0.f, 0.f, 0.f, 0.f}; }
        float rsl = 0.f;
        for (int ks = 0; ks < nk; ++ks) {
            if (ks == nk - 1) rsl = row_rs(c.part, mt * 128 + wm * 64 + lane);
            const bool tail = (ks + 2 >= nk);
            const hf* la = tail ? Apn + (ks + 2 - nk) * 32 : Ap + (ks + 2) * 32;
            const hf* lb = tail ? Bpn + (ks + 2 - nk) * 32 : Bp + (ks + 2) * 32;
            const int stn = st >= 1 ? st - 1 : 2;
            const char* sa = ldsb + st * 24576 + (wm * 64 + l15) * 64 + rpos;
            const char* sbp = ldsb + st * 24576 + 8192 + (wn * 128 + l15) * 64 + rpos;
            h8 af[4], bf[4];
#pragma unroll
            for (int i = 0; i < 4; ++i) af[i] = *(const h8*)(sa + i * 1024);
#pragma unroll
            for (int j = 0; j < 4; ++j) bf[j] = *(const h8*)(sbp + j * 1024);
            __builtin_amdgcn_sched_barrier(0);
            __builtin_amdgcn_s_setprio(1);
#pragma unroll
            for (int i = 0; i < 4; ++i)
#pragma unroll
                for (int j = 0; j < 4; ++j) acc0[i][j] = mfma16(bf[j], af[i], acc0[i][j]);
            __builtin_amdgcn_s_setprio(0);
            __builtin_amdgcn_sched_barrier(0);
#pragma unroll
            for (int j = 0; j < 4; ++j) bf[j] = *(const h8*)(sbp + (4 + j) * 1024);
            __builtin_amdgcn_sched_barrier(0);
            WIDE_DMA(la, lb, stn)
            __builtin_amdgcn_sched_barrier(0);
            __builtin_amdgcn_s_setprio(1);
#pragma unroll
            for (int i = 0; i < 4; ++i)
#pragma unroll
                for (int j = 0; j < 4; ++j) acc1[i][j] = mfma16(bf[j], af[i], acc1[i][j]);
            __builtin_amdgcn_s_setprio(0);
            __builtin_amdgcn_sched_barrier(0);
            asm volatile("s_waitcnt vmcnt(6)" ::: "memory");
            __builtin_amdgcn_s_barrier();
            asm volatile("" ::: "memory");
            st = st == 2 ? 0 : st + 1;
        }
        gemm_epilogue<EPI, 4>(acc0, rsl, mt * 128, nt * 256 + wn * 128, nt * 2 + wn, c, ep_scale, ep_g1, ep_g2, wm, 0, l15, lg);
        __builtin_amdgcn_sched_barrier(0);
        gemm_epilogue<EPI, 4>(acc1, rsl, mt * 128, nt * 256 + wn * 128, nt * 2 + wn, c, ep_scale, ep_g1, ep_g2, wm, 1, l15, lg);
        mt = mtn; nt = ntn; Ap = Apn; Bp = Bpn; have = haven;
    }
    asm volatile("s_waitcnt vmcnt(0)" ::: "memory");
    __syncthreads();
#undef WIDE_DMA
}

__device__ __forceinline__ unsigned cvt_pk_bf16(float lo, float hi) { unsigned r; asm("v_cvt_pk_bf16_f32 %0, %1, %2" : "=v"(r) : "v"(lo), "v"(hi)); return r; }
typedef unsigned u4 __attribute__((ext_vector_type(4)));

template <int MODE>
__device__ __forceinline__ void attn_wave(const hf* Q, int ldq, const hf* Kb, int ldk, const short* VT, int ntiles, int T_first,
                                          const uint64_t* mrow, float nbl2, float sink_p, hf* O, int ldo, int lane) {
    const int l15 = lane & 15, lg = lane >> 4;
    h8 qf[4][2];
#pragma unroll
    for (int qt = 0; qt < 4; ++qt)
#pragma unroll
        for (int kk = 0; kk < 2; ++kk) qf[qt][kk] = *(const h8*)(Q + (size_t)(qt * 16 + l15) * ldq + kk * 32 + lg * 8);
    f4 ot[4][4];
#pragma unroll
    for (int a = 0; a < 4; ++a)
#pragma unroll
        for (int b = 0; b < 4; ++b) ot[a][b] = (f4){0.f, 0.f, 0.f, 0.f};
    float lsum[4] = {0.f, 0.f, 0.f, 0.f};
    const hf* kbase = Kb + (size_t)((l15 >> 2) * 8 + (l15 & 3)) * ldk + lg * 8;
    const short* vbase = VT + (size_t)l15 * LP + lg * 8;
    h8 kfA[2][2], kfB[2][2];
    s8 vfA[4], vfB[4];
    uint64_t mw[4];
#define ATT_TILE(it_) ((MODE == 1) ? ((it_) == 0 ? 0 : T_first + (it_) - 1) : (it_))
#define ATT_LOAD_HALF(KF, VF, T_, HH)                                                                        \
    {                                                                                                        \
        _Pragma("unroll") for (int s2 = 0; s2 < 2; ++s2)                                                     \
            _Pragma("unroll") for (int kk = 0; kk < 2; ++kk)                                                 \
                KF[s2][kk] = *(const h8*)(kbase + (size_t)((T_) * 64 + (HH) * 32 + 4 * s2) * ldk + kk * 32);   \
        _Pragma("unroll") for (int dt = 0; dt < 4; ++dt) {                                                   \
            VF[dt] = *(const s8*)(vbase + (size_t)(dt * 16) * LP + (T_) * 64 + (HH) * 32);                   \
        }                                                                                                    \
    }
#define ATT_LOAD_MASK(MW, T_)                                                                                \
    {                                                                                                        \
        _Pragma("unroll") for (int qt = 0; qt < 4; ++qt) {                                                   \
            if (MODE == 0) MW[qt] = mrow[(size_t)(T_) * LP + qt * 16 + l15];                                 \
            else MW[qt] = ((T_) == 0) ? 0xFFFF000000000000ull : ~0ull;                                       \
        }                                                                                                    \
    }
#define ATT_COMPUTE(KF, VF, HH)                                                                              \
    {                                                                                                        \
        s8 pf[4];                                                                                            \
        _Pragma("unroll") for (int qt = 0; qt < 4; ++qt) {                                                   \
            f4 st0 = {0.f, 0.f, 0.f, 0.f}, st1 = {0.f, 0.f, 0.f, 0.f};                                       \
            st0 = mfma16(KF[0][0], qf[qt][0], st0); st0 = mfma16(KF[0][1], qf[qt][1], st0);                  \
            st1 = mfma16(KF[1][0], qf[qt][0], st1); st1 = mfma16(KF[1][1], qf[qt][1], st1);                  \
            const unsigned bits = (unsigned)(mw[qt] >> ((HH) * 32 + lg * 8));                                \
            float p0[4], p1[4];                                                                              \
            _Pragma("unroll") for (int r = 0; r < 4; ++r) {                                                  \
                p0[r] = __builtin_amdgcn_exp2f(st0[r] * LOG2E + nbl2); p0[r] = ((bits >> r) & 1u) ? p0[r] : 0.f;        \
                p1[r] = __builtin_amdgcn_exp2f(st1[r] * LOG2E + nbl2); p1[r] = ((bits >> (4 + r)) & 1u) ? p1[r] : 0.f;  \
                lsum[qt] += p0[r] + p1[r];                                                                   \
            }                                                                                                \
            u4 pk;                                                                                           \
            pk[0] = cvt_pk_bf16(p0[0], p0[1]); pk[1] = cvt_pk_bf16(p0[2], p0[3]);                            \
            pk[2] = cvt_pk_bf16(p1[0], p1[1]); pk[3] = cvt_pk_bf16(p1[2], p1[3]);                            \
            pf[qt] = __builtin_bit_cast(s8, pk);                                                             \
        }                                                                                                    \
        _Pragma("unroll") for (int dt = 0; dt < 4; ++dt)                                                     \
            _Pragma("unroll") for (int qt = 0; qt < 4; ++qt) ot[dt][qt] = mfma16b(VF[dt], pf[qt], ot[dt][qt]); \
    }
    {
        const int T0 = ATT_TILE(0);
        ATT_LOAD_MASK(mw, T0)
        ATT_LOAD_HALF(kfA, vfA, T0, 0)
    }
    for (int it = 0; it < ntiles; ++it) {
        const int T = ATT_TILE(it);
        const int itn = it + 1 < ntiles ? it + 1 : it;
        const int Tn = ATT_TILE(itn);
        ATT_LOAD_HALF(kfB, vfB, T, 1)
        __builtin_amdgcn_sched_barrier(0);
        ATT_COMPUTE(kfA, vfA, 0)
        __builtin_amdgcn_sched_barrier(0);
        ATT_LOAD_HALF(kfA, vfA, Tn, 0)
        __builtin_amdgcn_sched_barrier(0);
        ATT_COMPUTE(kfB, vfB, 1)
        __builtin_amdgcn_sched_barrier(0);
        ATT_LOAD_MASK(mw, Tn)
    }
#undef ATT_TILE
#undef ATT_LOAD_HALF
#undef ATT_LOAD_MASK
#undef ATT_COMPUTE
#pragma unroll
    for (int qt = 0; qt < 4; ++qt) {
        float l = lsum[qt];
        l += __shfl_xor(l, 16); l += __shfl_xor(l, 32);
        l += sink_p;
        const float inv = l > 0.f ? 1.0f / l : 0.f;
#pragma unroll
        for (int dt = 0; dt < 4; ++dt) {
            h4 o;
#pragma unroll
            for (int r = 0; r < 4; ++r) o[r] = (hf)(ot[dt][qt][r] * inv);
            *(h4*)(O + (size_t)(qt * 16 + l15) * ldo + dt * 16 + lg * 4) = o;
        }
    }
}

__device__ __forceinline__ void e2_item(const Ctx& c, int b, int ch, int qg, char* smem) {
    const int tid = tid_(), lane = tid & 63, w = tid >> 6, l15 = lane & 15, lg = lane >> 4;
    const hf* P = c.big;
    const int qrow0 = b * LP + ch * 64 + qg * 16;
    if (ch <= 3) {
        if (w <= ch && lane < 16) c.mask[((size_t)b * 33 + w) * LP + (qrow0 - b * LP) + lane] = (w == 0) ? 0xFFFF000000000000ull : ~0ull;
        return;
    }
    hf* iqs = (hf*)smem;
    unsigned* cnts = (unsigned*)(smem + 16 * 520 * 2);
#pragma unroll
    for (int i = 0; i < 4; ++i) {
        const int q = tid + 256 * i, row = q >> 6, cc = (q & 63) * 8;
        *(h8*)(iqs + row * 520 + cc) = *(const h8*)(P + (size_t)(qrow0 + row) * PLD + P_IQ + cc);
    }
    float iwf[8];
    {
        const h8 iwv = *(const h8*)(P + (size_t)(qrow0 + l15) * PLD + P_IW);
#pragma unroll
        for (int h = 0; h < 8; ++h) iwf[h] = (float)iwv[h];
    }
    __syncthreads();
    unsigned uk[8][4][4];
    unsigned uk0[4];
    h8 kn0, kn1;
    const hf* kpn;
    {
        const hf* kp = P + (size_t)(b * LP + 48 + l15) * PLD + P_IK + lg * 8;
        kn0 = *(const h8*)kp; kn1 = *(const h8*)(kp + 32);
    }
#define E2_SCORE(KF0, KF1, SC)                                                          \
    {                                                                                   \
        const hf* iqp_ = iqs + l15 * 520 + lg * 8;                                      \
        asm volatile("" : "+v"(iqp_));     \
        _Pragma("unroll") for (int h = 0; h < 8; ++h) {                                 \
            const h8 q0 = *(const h8*)(iqp_ + h * 64);                                  \
            const h8 q1 = *(const h8*)(iqp_ + h * 64 + 32);                             \
            f4 d = {0.f, 0.f, 0.f, 0.f};                                                \
            d = mfma16(KF0, q0, d);                                                     \
            d = mfma16(KF1, q1, d);                                                     \
            _Pragma("unroll") for (int r = 0; r < 4; ++r) SC[r] += iwf[h] * fmaxf(d[r], 0.f); \
            if (h == 3) __builtin_amdgcn_sched_barrier(0);                              \
        }                                                                               \
    }
#define E2_KEY(X) ({ unsigned u_ = __float_as_uint(X); if (u_ == 0x80000000u) u_ = 0u; (u_ & 0x80000000u) ? ~u_ : (u_ | 0x80000000u); })
    {
        const h8 kf0 = kn0, kf1 = kn1;
        kpn = P + (size_t)(b * LP + (1 + w) * 64 + l15) * PLD + P_IK + lg * 8;
        asm volatile("" : "+v"(kpn));
        kn0 = *(const h8*)kpn; kn1 = *(const h8*)(kpn + 32);
        f4 sc = {0.f, 0.f, 0.f, 0.f};
        E2_SCORE(kf0, kf1, sc)
#pragma unroll
        for (int r = 0; r < 4; ++r) { unsigned u = (w == 0) ? E2_KEY(sc[r]) : 0u; asm volatile("" : "+v"(u)); uk0[r] = u; }
        __builtin_amdgcn_sched_barrier(0);
    }
#pragma unroll
    for (int jj = 0; jj < 8; ++jj) {
        const int j = 1 + w + 4 * jj;
        if (j <= ch) {
#pragma unroll
            for (int sub = 0; sub < 4; ++sub) {
                const h8 kf0 = kn0, kf1 = kn1;
                {
                    const int jn = (sub == 3) ? j + 4 : j;
                    kpn += (sub == 3) ? (size_t)208 * PLD : (size_t)16 * PLD;
                    asm volatile("" : "+v"(kpn));
                    if (jn <= ch && (sub < 3 || jj < 7)) { kn0 = *(const h8*)kpn; kn1 = *(const h8*)(kpn + 32); }
                }
                f4 sc = {0.f, 0.f, 0.f, 0.f};
                E2_SCORE(kf0, kf1, sc)
#pragma unroll
                for (int r = 0; r < 4; ++r) { unsigned u = E2_KEY(sc[r]); asm volatile("" : "+v"(u)); uk[jj][sub][r] = u; }
                __builtin_amdgcn_sched_barrier(0);
            }
        } else {
#pragma unroll
            for (int sub = 0; sub < 4; ++sub)
#pragma unroll
                for (int r = 0; r < 4; ++r) uk[jj][sub][r] = 0u;
        }
    }
    unsigned prefix = 0u;
    bool done = false;
    for (int bit = 31; bit >= 0; --bit) {
        const unsigned cand = prefix | (1u << bit);
        int cnt = 0;
#pragma unroll
        for (int r = 0; r < 4; ++r) cnt += (uk0[r] >= cand) ? 1 : 0;
#pragma unroll
        for (int jj = 0; jj < 8; ++jj) {
            if (1 + w + 4 * jj <= ch) {
#pragma unroll
                for (int sub = 0; sub < 4; ++sub)
#pragma unroll
                    for (int r = 0; r < 4; ++r) cnt += (uk[jj][sub][r] >= cand) ? 1 : 0;
            }
        }
        cnt += __shfl_xor(cnt, 16); cnt += __shfl_xor(cnt, 32);
        const int pb = (bit & 1) * 64;
        if (lane < 16) cnts[pb + w * 16 + lane] = (unsigned)cnt;
        __syncthreads();
        const int tot = (int)(cnts[pb + l15] + cnts[pb + 16 + l15] + cnts[pb + 32 + l15] + cnts[pb + 48 + l15]);
        if (!done) {
            if (tot >= 256) prefix = cand;
            if (tot == 256) done = true;
        }
        if (__all(done ? 1 : 0)) break;
    }
#define E2_TOTAL(CNT, PAR)                                                                                   \
    ({                                                                                                       \
        int c_ = (CNT);                                                                                      \
        c_ += __shfl_xor(c_, 16); c_ += __shfl_xor(c_, 32);                                                  \
        const int pb_ = (PAR) * 64;                                                                          \
        if (lane < 16) cnts[pb_ + w * 16 + lane] = (unsigned)c_;                                             \
        __syncthreads();                                                                                     \
        (int)(cnts[pb_ + l15] + cnts[pb_ + 16 + l15] + cnts[pb_ + 32 + l15] + cnts[pb_ + 48 + l15]);         \
    })
    __syncthreads();
    int X = 2112;
    if (!__all(done ? 1 : 0)) {
        int cge = 0, cgt = 0;
#pragma unroll
        for (int r = 0; r < 4; ++r) { cge += (uk0[r] >= prefix) ? 1 : 0; cgt += (uk0[r] > prefix) ? 1 : 0; }
#pragma unroll
        for (int jj = 0; jj < 8; ++jj) {
            if (1 + w + 4 * jj <= ch) {
#pragma unroll
                for (int sub = 0; sub < 4; ++sub)
#pragma unroll
                    for (int r = 0; r < 4; ++r) { cge += (uk[jj][sub][r] >= prefix) ? 1 : 0; cgt += (uk[jj][sub][r] > prefix) ? 1 : 0; }
            }
        }
        const int tot = E2_TOTAL(cge | (cgt << 16), 0);
        const int tge = tot & 0xFFFF, tgt = tot >> 16;
        const int need = 256 - tgt;
        const bool tie = (tge - tgt) > need;
        if (__any(tie ? 1 : 0)) {
            int lo = 0, hi = 2112;
            for (int itb = 0; itb < 12; ++itb) {
                const int mid = (lo + hi) >> 1;
                const int tm = mid - lg * 4;
                const int tmw = tm - w * 64;
                int cq = 0;
#pragma unroll
                for (int r = 0; r < 4; ++r) cq += (uk0[r] == prefix && (48 + r) < tm) ? 1 : 0;
#pragma unroll
                for (int jj = 0; jj < 8; ++jj) {
                    if (1 + w + 4 * jj <= ch) {
#pragma unroll
                        for (int sub = 0; sub < 4; ++sub)
#pragma unroll
                            for (int r = 0; r < 4; ++r)
                                cq += (uk[jj][sub][r] == prefix && ((1 + 4 * jj) * 64 + sub * 16 + r) < tmw) ? 1 : 0;
                    }
                }
                const int t2 = E2_TOTAL(cq, (itb + 1) & 1);
                if (t2 >= need) hi = mid; else lo = mid + 1;
            }
            if (tie) X = hi;
        }
    }
    const int XL = X - lg * 4, XLW = XL - w * 64;
#define E2_SEL(U, IDXC, XB) (((U) > prefix) || ((U) == prefix && (IDXC) < (XB)))
    if (w == 0) {
        unsigned m4 = 0u;
#pragma unroll
        for (int r = 0; r < 4; ++r) m4 |= E2_SEL(uk0[r], 48 + r, XL) ? (1u << r) : 0u;
        unsigned hi = m4 << (16 + lg * 4);
        hi |= __shfl_xor(hi, 16); hi |= __shfl_xor(hi, 32);
        if (lg == 0) c.mask[((size_t)b * 33 + 0) * LP + (qrow0 - b * LP) + l15] = ((uint64_t)hi << 32);
    }
#pragma unroll
    for (int jj = 0; jj < 8; ++jj) {
        const int j = 1 + w + 4 * jj;
        if (j <= ch) {
            unsigned lo = 0u, hi = 0u;
#pragma unroll
            for (int sub = 0; sub < 4; ++sub) {
                unsigned m4 = 0u;
#pragma unroll
                for (int r = 0; r < 4; ++r) m4 |= E2_SEL(uk[jj][sub][r], (1 + 4 * jj) * 64 + sub * 16 + r, XLW) ? (1u << r) : 0u;
                m4 <<= (lg * 4);
                if (sub == 0) lo |= m4; else if (sub == 1) lo |= m4 << 16; else if (sub == 2) hi |= m4; else hi |= m4 << 16;
            }
            lo |= __shfl_xor(lo, 16); lo |= __shfl_xor(lo, 32);
            hi |= __shfl_xor(hi, 16); hi |= __shfl_xor(hi, 32);
            if (lg == 0) c.mask[((size_t)b * 33 + j) * LP + (qrow0 - b * LP) + l15] = ((uint64_t)hi << 32) | (uint64_t)lo;
        }
    }
#undef E2_TOTAL
#undef E2_SEL
#undef E2_SCORE
#undef E2_KEY
}

__device__ __forceinline__ void retention_item(const Ctx& c, int b, int h, char* smem) {
    const int tid = tid_(), lane = tid & 63, w = tid >> 6, l15 = lane & 15, lg = lane >> 4;
    hf* P = c.big;
    const float l2g = __log2f(1.0f - exp2f(-5.0f - (float)h));
    const int prow = (l15 >> 2) * 8 + (l15 & 3);
    const hf* Pb = P + (size_t)b * LP * PLD;
    const hf* KDT = c.bkdT + ((size_t)(b * 8 + h) * 64) * LP;
    const hf* VT = c.bvT + ((size_t)(b * 8 + h) * 128 + w * 32) * LP;
    float* parts = (float*)smem;
    f4 S[4][2];
#pragma unroll
    for (int td = 0; td < 4; ++td)
#pragma unroll
        for (int te = 0; te < 2; ++te) S[td][te] = (f4){0.f, 0.f, 0.f, 0.f};
    const float cdec = exp2f(64.0f * l2g);
    float qdec[4];
#pragma unroll
    for (int ti = 0; ti < 4; ++ti) qdec[ti] = exp2f((float)(ti * 16 + l15 + 1) * l2g);
    for (int n = 0; n < 33; ++n) {
        const int row0 = n * 64;
        h8 qf[4][2];
#pragma unroll
        for (int ti = 0; ti < 4; ++ti)
#pragma unroll
            for (int kk = 0; kk < 2; ++kk) {
                qf[ti][kk] = *(const h8*)(Pb + (size_t)(row0 + ti * 16 + l15) * PLD + P_BQ + h * 64 + kk * 32 + lg * 8);
            }
        f4 out[2][4];
#pragma unroll
        for (int te = 0; te < 2; ++te)
#pragma unroll
            for (int ti = 0; ti < 4; ++ti) out[te][ti] = (f4){0.f, 0.f, 0.f, 0.f};
        if (n > 0) {
            h8 sf[2][2];
#pragma unroll
            for (int tdp = 0; tdp < 2; ++tdp)
#pragma unroll
                for (int te = 0; te < 2; ++te) {
                    h8 t;
#pragma unroll
                    for (int r = 0; r < 4; ++r) { t[r] = (hf)S[2 * tdp][te][r]; t[4 + r] = (hf)S[2 * tdp + 1][te][r]; }
                    sf[tdp][te] = t;
                }
#pragma unroll
            for (int te = 0; te < 2; ++te)
#pragma unroll
                for (int ti = 0; ti < 4; ++ti) {
                    f4 o = {0.f, 0.f, 0.f, 0.f};
                    o = mfma16(sf[0][te], qf[ti][0], o);
                    o = mfma16(sf[1][te], qf[ti][1], o);
                    out[te][ti] = o * qdec[ti];
                }
        }
        h8 vfs[2][2];
#pragma unroll
        for (int tjp = 0; tjp < 2; ++tjp) {
            h8 kf[2][2];
#pragma unroll
            for (int s2 = 0; s2 < 2; ++s2)
#pragma unroll
                for (int kk = 0; kk < 2; ++kk) {
                    kf[s2][kk] = *(const h8*)(Pb + (size_t)(row0 + tjp * 32 + prow + 4 * s2) * PLD + P_BK + h * 64 + kk * 32 + lg * 8);
                }
#pragma unroll
            for (int te = 0; te < 2; ++te) {
                vfs[tjp][te] = *(const h8*)(VT + (size_t)(te * 16 + l15) * LP + row0 + tjp * 32 + lg * 8);
            }
            h8 pf[4];
#pragma unroll
            for (int ti = 0; ti < 4; ++ti) {
                f4 a0 = {0.f, 0.f, 0.f, 0.f}, a1 = {0.f, 0.f, 0.f, 0.f};
                a0 = mfma16(kf[0][0], qf[ti][0], a0); a0 = mfma16(kf[0][1], qf[ti][1], a0);
                a1 = mfma16(kf[1][0], qf[ti][0], a1); a1 = mfma16(kf[1][1], qf[ti][1], a1);
                const int i = ti * 16 + l15;
                h8 t;
#pragma unroll
                for (int r = 0; r < 4; ++r) {
                    const int j0 = tjp * 32 + lg * 8 + r, j1 = j0 + 4;
                    const float d0 = (i >= j0) ? exp2f((float)(i - j0) * l2g) : 0.f;
                    const float d1 = (i >= j1) ? exp2f((float)(i - j1) * l2g) : 0.f;
                    t[r] = (hf)(a0[r] * d0); t[4 + r] = (hf)(a1[r] * d1);
                }
                pf[ti] = t;
            }
#pragma unroll
            for (int te = 0; te < 2; ++te)
#pragma unroll
                for (int ti = 0; ti < 4; ++ti) out[te][ti] = mfma16(vfs[tjp][te], pf[ti], out[te][ti]);
        }
        if (n < 32)
#pragma unroll
        for (int td = 0; td < 4; ++td) {
            h8 kd[2];
#pragma unroll
            for (int tjp = 0; tjp < 2; ++tjp) {
                kd[tjp] = *(const h8*)(KDT + (size_t)((td >> 1) * 32 + prow + 4 * (td & 1)) * LP + row0 + tjp * 32 + lg * 8);
            }
#pragma unroll
            for (int te = 0; te < 2; ++te) {
                f4 s = S[td][te] * cdec;
                s = mfma16(kd[0], vfs[0][te], s);
                s = mfma16(kd[1], vfs[1][te], s);
                S[td][te] = s;
            }
        }
        float ss[4];
#pragma unroll
        for (int ti = 0; ti < 4; ++ti) {
            float a = 0.f;
#pragma unroll
            for (int te = 0; te < 2; ++te)
#pragma unroll
                for (int r = 0; r < 4; ++r) a += out[te][ti][r] * out[te][ti][r];
            a += __shfl_xor(a, 16); a += __shfl_xor(a, 32);
            ss[ti] = a;
        }
        const int pb = (n & 1) * 256;
        if (lg == 0) {
#pragma unroll
            for (int ti = 0; ti < 4; ++ti) parts[pb + w * 64 + ti * 16 + l15] = ss[ti];
        }
        __syncthreads();
#pragma unroll
        for (int ti = 0; ti < 4; ++ti) {
            const int ii = ti * 16 + l15;
            const float tot = (parts[pb + ii] + parts[pb + 64 + ii]) + (parts[pb + 128 + ii] + parts[pb + 192 + ii]);
            const float rsn = rsqrtf(tot * (1.0f / 128.0f) + 1e-6f);
#pragma unroll
            for (int te = 0; te < 2; ++te) {
                hf* gp = P + (size_t)(b * LP + row0 + ii) * PLD + P_SBG + h * 128 + w * 32 + te * 16 + lg * 4;
                const h4 gv = *(const h4*)gp;
                h4 o;
#pragma unroll
                for (int r = 0; r < 4; ++r) o[r] = (hf)(out[te][ti][r] * rsn * (float)gv[r]);
                *(h4*)gp = o;
            }
        }
    }
    __syncthreads();
}

__device__ __forceinline__ void pool_item(const Ctx& c, int it) {
    hf* P2 = c.big;
    const int tid = tid_();
#pragma unroll 1
    for (int k = 0; k < 8; ++k) {
        const int q = tid + 256 * k;
        const int row = it * 32 + (q >> 6), ch0 = (q & 63) * 8;
        const int pp = row % LP;
        h8 o;
        if (pp < 48) {
#pragma unroll
            for (int e = 0; e < 8; ++e) o[e] = (hf)0.f;
        } else {
            const int wnd = 2 << (ch0 >> 7);
            float a[8];
#pragma unroll
            for (int e = 0; e < 8; ++e) a[e] = 0.f;
            const hf* xp = P2 + (size_t)row * P2LD + P2_DX + ch0;
            const h8 x0 = *(const h8*)xp;
            for (int t = 0; t < wnd; ++t) {
                const h8 v = *(const h8*)(xp - (size_t)t * P2LD);
#pragma unroll
                for (int e = 0; e < 8; ++e) a[e] += (float)v[e];
            }
            int cnt = pp - 47; cnt = cnt < wnd ? cnt : wnd;
            const float ic = 1.0f / (float)cnt;
#pragma unroll
            for (int e = 0; e < 8; ++e) o[e] = (hf)(a[e] * ic - (float)x0[e]);
        }
        *(h8*)(P2 + (size_t)row * P2LD + P2_YD + ch0) = o;
    }
}

__global__ void __launch_bounds__(256, 2) fwd_megakernel(Params p) {
    __shared__ __attribute__((aligned(16))) char smem[SMEM_BYTES];
    __shared__ uint4 xb_words;
    if (threadIdx.x == 0) xb_words = make_uint4(0u, 0u, 0u, 0u);
    __syncthreads();
    XcdBarrier xb = xcd_barrier_post((unsigned*)(p.ws + WS_BAR), (volatile LAS unsigned*)&xb_words);
    {
        unsigned* sl = (unsigned*)(p.ws + WS_SLOT);
        if (threadIdx.x == 0) { volatile LAS unsigned* st = (volatile LAS unsigned*)&xb_words; st[2] = xb_add(&sl[xb.x * 64], 1u); }
    }
    Ctx c;
    c.W = (hf*)p.ws;
    c.h16 = (hf*)(p.ws + WS_H16);
    c.part = (float*)(p.ws + WS_PART);
    c.bkdT = (hf*)(p.ws + WS_BKDT);
    c.big = (hf*)(p.ws + WS_BIG);
    char* dob = (char*)p.out;
    c.avT = (short*)(dob + DO_AVT);
    c.bvT = (hf*)(dob + DO_BVT);
    c.mask = (uint64_t*)(dob + DO_MASK);
    c.cvT = (short*)(dob + DO_CVT);
    c.out = p.out;
    c.xcd = blockIdx.x & 7; c.slot = blockIdx.x >> 3; c.nslots = gridDim.x >> 3;
#pragma unroll 1
    for (int ph = 0; ph < 16; ++ph) {
        int kind;
        switch (ph) {
            case 0: kind = 0; break;
            case 1: case 7: case 9: case 14: kind = 1; break;
            case 2: case 6: case 8: case 10: case 13: kind = 2; break;
            case 3: kind = 3; break;
            case 4: kind = 4; break;
            case 5: kind = 5; break;
            case 11: kind = 6; break;
            case 12: kind = 7; break;
            default: kind = 8; break;
        }
        if (kind == 0) {
            prologue(p, c, smem);
        } else if (kind == 1) {
            const int wi = (ph == 1) ? 0 : (ph == 7) ? 1 : (ph == 9) ? 2 : 3;
            gemm_wide<EPI_SWIGLU>(c.h16, 1024, c.W + OFF_WFI(wi), 5632, 1024, c, 0.f, nullptr, nullptr, smem);
        } else if (kind == 2) {
            const hf* Bt; int lda, K; float scale;
            if (ph == 6) { Bt = c.W + OFF_WEO; lda = PLD; K = 1536; scale = 1.0f; }
            else if (ph == 13) { Bt = c.W + OFF_WOO; lda = P2LD; K = 1024; scale = 1.0f; }
            else { const int wi = (ph == 2) ? 0 : (ph == 8) ? 1 : 2; Bt = c.W + OFF_WFO(wi); lda = DFF; K = DFF; scale = 0.5f; }
            gemm_phase<EPI_RESID, 3>(c.big, lda, Bt, 1024, K, c, scale, nullptr, nullptr, smem);
        } else if (kind == 3) {
            gemm_phase<EPI_EVEN, 4>(c.h16, 1024, c.W + OFF_WEI, 5248, 1024, c, 0.f, p.ev_a_q_norm, p.ev_a_k_norm, smem);
        } else if (kind == 4) {
            if (bid_() < 64) {
                xcd_barrier_arrive(xb);
                retention_item(c, bid_() >> 3, bid_() & 7, smem);
            } else {
                const int nb = nblk_() - 64, me = bid_() - 64;
                for (int rnd = 0; rnd * nb < 33 * 32; ++rnd) {
                    const int idx = rnd * nb + ((rnd & 1) ? (nb - 1 - me) : me);
                    if (idx < 33 * 32) {
                        const int ch = 32 - idx / 32, rem = idx % 32;
                        e2_item(c, rem >> 2, ch, rem & 3, smem);
                    }
                    __syncthreads();
                }
            }
        } else if (kind == 5) {
            const int tid = tid_(), lane = tid & 63, w = tid >> 6;
            const float gq = wave_maxabs64(p.ev_a_q_norm, lane), gk = wave_maxabs64(p.ev_a_k_norm, lane);
            const float nbl2 = -(8.0f * gq * gk) * LOG2E;
            if (bid_() < 64) xcd_barrier_wait(xb);
            else
            for (int idx = bid_() - 64; idx < 33 * 16; idx += nblk_() - 64) {
                const int ch = 32 - idx / 16, rem = idx % 16;
                const int b = rem >> 1, hg = rem & 1, h = hg * 4 + w;
                hf* Q = c.big + (size_t)(b * LP + ch * 64) * PLD + P_AQ + h * 64;
                const hf* Kb = c.big + (size_t)(b * LP) * PLD + P_AK + h * 64;
                const short* VT = c.avT + ((size_t)(b * 8 + h) * 64) * LP;
                const uint64_t* mrow = c.mask + (size_t)b * 33 * LP + ch * 64;
                attn_wave<0>(Q, PLD, Kb, PLD, VT, ch + 1, 0, mrow, nbl2, 0.f, Q, PLD, lane);
            }
        } else if (kind == 6) {
            gemm_phase<EPI_ODD, 4>(c.h16, 1024, c.W + OFF_WOI, 1280, 1024, c, 0.f, p.od_c_q_norm, p.od_c_k_norm, smem);
        } else if (kind == 7) {
            const int tid = tid_(), lane = tid & 63, w = tid >> 6;
            const float gq = wave_maxabs64(p.od_c_q_norm, lane), gk = wave_maxabs64(p.od_c_k_norm, lane);
            float smax = p.od_c_sinks[lane & 7];
#pragma unroll
            for (int o = 4; o >= 1; o >>= 1) smax = fmaxf(smax, __shfl_xor(smax, o));
            const float bound = fmaxf(8.0f * gq * gk, smax);
            const float nbl2 = -bound * LOG2E;
            for (int idx = bid_(); idx < 528 + 528; idx += nblk_()) {
                if (idx < 528) {
                    const int n = idx / 16, rem = idx % 16;
                    const int b = rem >> 1, g = rem & 1, h = g * 4 + w;
                    hf* Q = c.big + (size_t)(b * LP + n * 64) * P2LD + P2_CQ + h * 64;
                    const hf* Kb = c.big + (size_t)(b * LP) * P2LD + P2_CK + g * 64;
                    const short* VT = c.cvT + ((size_t)(b * 2 + g) * 64) * LP;
                    const int T_first = n - 2 > 1 ? n - 2 : 1;
                    const int nband = n >= T_first ? n - T_first + 1 : 0;
                    const float sink_p = exp2f(p.od_c_sinks[h] * LOG2E + nbl2);
                    attn_wave<1>(Q, P2LD, Kb, P2LD, VT, 1 + nband, T_first, nullptr, nbl2, sink_p, Q, P2LD, lane);
                } else {
                    pool_item(c, idx - 528);
                }
            }
        } else {
            gemm_phase<EPI_FINAL, 3>(c.big, DFF, c.W + OFF_WFO(3), 1024, DFF, c, 0.5f, nullptr, nullptr, smem);
        }
        if (ph < 15 && !(ph == 4 && bid_() < 64)) xcd_barrier(xb);
        if (ph == 0) {
            volatile LAS unsigned* st = (volatile LAS unsigned*)&xb_words;
            const unsigned nloc = __builtin_amdgcn_readfirstlane(st[0]), nx = __builtin_amdgcn_readfirstlane(st[1]);
            if (nx == 8u && nloc * 8u == gridDim.x && xb.x < 8u) { c.xcd = __builtin_amdgcn_readfirstlane((int)xb.x); c.slot = __builtin_amdgcn_readfirstlane((int)st[2]); c.nslots = __builtin_amdgcn_readfirstlane((int)nloc); }
        }
    }
}

extern "C" void kernel_launch(void* const* d_in, const int* in_sizes, int n_in, void* d_out, int out_size, void* d_ws, size_t ws_size,
                              hipStream_t stream) {
    static int grid_blocks = 0;
    if (!grid_blocks) {
        int dev = 0, cus = 0, per_cu = 0;
        hipGetDevice(&dev);
        hipDeviceGetAttribute(&cus, hipDeviceAttributeMultiprocessorCount, dev);
        hipOccupancyMaxActiveBlocksPerMultiprocessor(&per_cu, fwd_megakernel, 256, 0);
        if (per_cu > 2) per_cu = 2;
        if (per_cu < 1) per_cu = 1;
        grid_blocks = cus * per_cu;
    }
    if (ws_size < WS_END) { fprintf(stderr, "workspace too small: %zu < %zu\n", ws_size, (size_t)WS_END); return; }
    Params p{};
    p.x = (const float*)d_in[0]; p.meta = (const float*)d_in[1]; p.ffn1_norm = (const float*)d_in[2];
    p.ffn1_w_in = (const float*)d_in[3]; p.ffn1_w_out = (const float*)d_in[4]; p.mix_norm = (const float*)d_in[5];
    p.ffn2_norm = (const float*)d_in[6]; p.ffn2_w_in = (const float*)d_in[7]; p.ffn2_w_out = (const float*)d_in[8];
    p.ev_w_in = (const float*)d_in[9]; p.ev_a_q_norm = (const float*)d_in[10]; p.ev_a_k_norm = (const float*)d_in[11];
    p.ev_w_out = (const float*)d_in[12]; p.od_w_in = (const float*)d_in[13]; p.od_c_q_norm = (const float*)d_in[14];
    p.od_c_k_norm = (const float*)d_in[15]; p.od_c_sinks = (const float*)d_in[16]; p.od_d_mix = (const float*)d_in[17];
    p.od_d_scale = (const float*)d_in[18]; p.od_w_out = (const float*)d_in[19];
    p.out = (float*)d_out; p.ws = (char*)d_ws;
    hipMemsetAsync((char*)d_ws + WS_BAR, 0, 16384 + 4096, stream);
    void* args[] = {&p};
    hipError_t e = hipLaunchCooperativeKernel((void*)fwd_megakernel, dim3(grid_blocks), dim3(256), args, 0, stream);
    if (e != hipSuccess) fprintf(stderr, "cooperative launch failed: %s (grid %d)\n", hipGetErrorString(e), grid_blocks);
}
```

```cpp
#include <hip/hip_runtime.h>
#include <hip/hip_cooperative_groups.h>
#include <stdint.h>
#include <stdio.h>
namespace cg = cooperative_groups;

typedef _Float16 hf;
typedef _Float16 h8 __attribute__((ext_vector_type(8)));
typedef _Float16 h4 __attribute__((ext_vector_type(4)));
typedef short s8 __attribute__((ext_vector_type(8)));
typedef short s4 __attribute__((ext_vector_type(4)));
typedef float f4 __attribute__((ext_vector_type(4)));

#define NB 8
#define LP 2112
#define TP 16896
#define DM 1024
#define DFF 2816
#define PLD 3712
#define P_AQ 0
#define P_SBG 512
#define P_AK 1536
#define P_IQ 2048
#define P_IK 2560
#define P_IW 2624
#define P_BQ 2688
#define P_BK 3200
#define P2LD 1664
#define P2_CQ 0
#define P2_YD 512
#define P2_CK 1024
#define P2_DX 1152
#define LOG2E 1.4426950408889634f
#define SMEM_BYTES 73728

#define W_FFN_IN ((size_t)5632 * 1024)
#define W_FFN_OUT ((size_t)1024 * 2816)
#define OFF_WFI(i) ((size_t)(i) * W_FFN_IN)
#define OFF_WFO(i) (4 * W_FFN_IN + (size_t)(i) * W_FFN_OUT)
#define OFF_WEI (4 * W_FFN_IN + 4 * W_FFN_OUT)
#define OFF_WEO (OFF_WEI + (size_t)5376 * 1024)
#define OFF_WOI (OFF_WEO + (size_t)1024 * 1536)
#define OFF_WOO (OFF_WOI + (size_t)1280 * 1024)
#define W_TOTAL (OFF_WOO + (size_t)1024 * 1024)
#define WS_H16 (W_TOTAL * 2)
#define WS_PART (WS_H16 + (size_t)TP * 1024 * 2)
#define WS_BKDT (WS_PART + (size_t)TP * 16 * 4)
#define WS_BIG (WS_BKDT + (size_t)TP * 512 * 2)
#define WS_BAR (WS_BIG + (size_t)TP * PLD * 2)
#define WS_SLOT (WS_BAR + 16384)
#define WS_END (WS_SLOT + 4096)
#define DO_AVT ((size_t)0)
#define DO_BVT ((size_t)TP * 512 * 2)
#define DO_MASK (DO_BVT + (size_t)TP * 1024 * 2)
#define DO_CVT (DO_MASK + (size_t)TP * 33 * 8)

__constant__ float ROT_INV[32] = {
    1.000000000e+00f, 7.498942018e-01f, 5.623413324e-01f, 4.216965139e-01f, 3.162277639e-01f, 2.371373922e-01f,
    1.778279394e-01f, 1.333521456e-01f, 1.000000015e-01f, 7.498941571e-02f, 5.623412877e-02f, 4.216964915e-02f,
    3.162277862e-02f, 2.371373586e-02f, 1.778279431e-02f, 1.333521493e-02f, 9.999999776e-03f, 7.498942316e-03f,
    5.623413250e-03f, 4.216964822e-03f, 3.162277862e-03f, 2.371373819e-03f, 1.778279431e-03f, 1.333521446e-03f,
    1.000000047e-03f, 7.498941850e-04f, 5.623413017e-04f, 4.216965463e-04f, 3.162277862e-04f, 2.371373848e-04f,
    1.778279402e-04f, 1.333521504e-04f};

struct Params {
    const float* x; const float* meta; const float* ffn1_norm; const float* ffn1_w_in; const float* ffn1_w_out;
    const float* mix_norm; const float* ffn2_norm; const float* ffn2_w_in; const float* ffn2_w_out;
    const float* ev_w_in; const float* ev_a_q_norm; const float* ev_a_k_norm; const float* ev_w_out;
    const float* od_w_in; const float* od_c_q_norm; const float* od_c_k_norm; const float* od_c_sinks;
    const float* od_d_mix; const float* od_d_scale; const float* od_w_out;
    float* out; char* ws;
};

struct Ctx {
    hf* W; hf* h16; float* part; hf* bkdT; hf* big;
    short* avT; hf* bvT; uint64_t* mask; short* cvT; float* out;
    int xcd, slot, nslots;
};

__device__ __forceinline__ int tid_() { int t = threadIdx.x; asm volatile("" : "+v"(t)); return t; }
__device__ __forceinline__ int bid_() { int b = blockIdx.x; asm volatile("" : "+s"(b)); return b; }
__device__ __forceinline__ int nblk_() { int b = gridDim.x; asm volatile("" : "+s"(b)); return b; }
__device__ __forceinline__ f4 mfma16(h8 a, h8 b, f4 c) { return __builtin_amdgcn_mfma_f32_16x16x32_f16(a, b, c, 0, 0, 0); }
__device__ __forceinline__ f4 mfma16b(s8 a, s8 b, f4 c) { return __builtin_amdgcn_mfma_f32_16x16x32_bf16(a, b, c, 0, 0, 0); }
__device__ __forceinline__ unsigned short f2bf(float f) {
    unsigned u = __float_as_uint(f);
    u += 0x7FFFu + ((u >> 16) & 1u);
    return (unsigned short)(u >> 16);
}
__device__ __forceinline__ float silu_f(float x) { return x * __builtin_amdgcn_rcpf(1.0f + __builtin_amdgcn_exp2f(-x * LOG2E)); }
__device__ __forceinline__ float row_rs(const float* part, int m) {
    const f4* p = (const f4*)(part + (size_t)m * 16);
    f4 a = p[0], b = p[1], c = p[2], d = p[3];
    float s = (((a[0] + a[1]) + (a[2] + a[3])) + ((b[0] + b[1]) + (b[2] + b[3]))) +
              (((c[0] + c[1]) + (c[2] + c[3])) + ((d[0] + d[1]) + (d[2] + d[3])));
    return rsqrtf(s * (1.0f / 1024.0f) + 1e-6f);
}
__device__ __forceinline__ float wave_maxabs64(const float* g, int lane) {
    float v = fabsf(g[lane]);
#pragma unroll
    for (int o = 32; o >= 1; o >>= 1) v = fmaxf(v, __shfl_xor(v, o));
    return v;
}
__device__ __forceinline__ h8 cat44(h4 a, h4 b) {
    h8 r; r[0] = a[0]; r[1] = a[1]; r[2] = a[2]; r[3] = a[3]; r[4] = b[0]; r[5] = b[1]; r[6] = b[2]; r[7] = b[3]; return r;
}
__device__ __forceinline__ s8 cat44s(s4 a, s4 b) {
    s8 r; r[0] = a[0]; r[1] = a[1]; r[2] = a[2]; r[3] = a[3]; r[4] = b[0]; r[5] = b[1]; r[6] = b[2]; r[7] = b[3]; return r;
}


#define XB_TMO      128
#define XB_XCNT(j)  (256  + 64 * (j))
#define XB_XSUB(j)  (1280 + 64 * (j))
#define XB_XGEN(j)  (2304 + 64 * (j))
#define XB_TOP      3328
#define XB_TOPGEN   3392
#define XCD_BAR_WORDS 3456
#define XB_SPIN_CAP (1u << 18)
#define LAS __attribute__((address_space(3)))
__device__ __forceinline__ unsigned xb_ld(unsigned* p)              { return __hip_atomic_load(p, __ATOMIC_RELAXED, __HIP_MEMORY_SCOPE_AGENT); }
__device__ __forceinline__ unsigned xb_add(unsigned* p, unsigned v) { return __hip_atomic_fetch_add(p, v, __ATOMIC_RELAXED, __HIP_MEMORY_SCOPE_AGENT); }
__device__ __forceinline__ unsigned xb_xcc_id() { return (unsigned)__builtin_amdgcn_s_getreg((3 << 11) | 20) & 0xFu; }
#define XB_SPIN(cond, bar) do { unsigned _sp = 0; while (cond) { __builtin_amdgcn_s_sleep(1); \
    if ((++_sp & 255u) == 0u) { if (xb_ld(&(bar)[XB_TMO])) break; if (_sp > XB_SPIN_CAP) { atomicAdd(&(bar)[XB_TMO], 1u); break; } } } } while (0)
struct XcdBarrier { unsigned* bar; unsigned x; volatile LAS unsigned* st; };
__device__ __forceinline__ XcdBarrier xcd_barrier_post(unsigned* bar, volatile LAS unsigned* st) {
    XcdBarrier b; b.bar = bar; b.x = xb_xcc_id(); b.st = st;
    if (threadIdx.x == 0) (void)xb_add(&bar[XB_XCNT(b.x)], 1u);
    return b;
}
__device__ __forceinline__ void xcd_barrier_complete(unsigned* bar, unsigned x, unsigned& nloc, unsigned& nx) {
    const unsigned G = gridDim.x * gridDim.y * gridDim.z;
    unsigned sum, cnt, mine, sp = 0u;
    for (;;) {
        sum = 0u; cnt = 0u; mine = 0u;
#pragma unroll
        for (unsigned j = 0; j < 16; ++j) { const unsigned c = xb_ld(&bar[XB_XCNT(j)]); sum += c; cnt += (c > 0u) ? 1u : 0u; mine = (j == x) ? c : mine; }
        if (sum == G) break;
        __builtin_amdgcn_s_sleep(1);
        if ((++sp & 255u) == 0u) { if (xb_ld(&bar[XB_TMO])) break; if (sp > XB_SPIN_CAP) { atomicAdd(&bar[XB_TMO], 1u); break; } }
    }
    nloc = mine > 0u ? mine : 1u; nx = cnt > 0u ? cnt : 1u;
}
__device__ __forceinline__ void xcd_barrier(const XcdBarrier& b) {
    asm volatile("s_waitcnt vmcnt(0)" ::: "memory");
    __syncthreads();
    if (threadIdx.x == 0) {
        unsigned* bar = b.bar;
        __builtin_amdgcn_s_waitcnt(0);
        unsigned nloc = b.st[0], nx = b.st[1];
        if (nloc == 0u) { xcd_barrier_complete(bar, b.x, nloc, nx); b.st[0] = nloc; b.st[1] = nx; }
        const unsigned old = xb_add(&bar[XB_XSUB(b.x)], 1u);
        const unsigned gen = old / nloc;
        if (old + 1u == (gen + 1u) * nloc) {
            __builtin_amdgcn_fence(__ATOMIC_RELEASE, "agent");
            asm volatile("s_waitcnt vmcnt(0)" ::: "memory");
            const unsigned og = xb_add(&bar[XB_TOP], 1u);
            const unsigned tg = og / nx;
            if (og + 1u == (tg + 1u) * nx) xb_add(&bar[XB_TOPGEN], 1u);
            else XB_SPIN(xb_ld(&bar[XB_TOPGEN]) == tg, bar);
            __builtin_amdgcn_fence(__ATOMIC_ACQUIRE, "agent");
            xb_add(&bar[XB_XGEN(b.x)], 1u);
            asm volatile("s_waitcnt vmcnt(0)" ::: "memory");
        } else {
            XB_SPIN(xb_ld(&bar[XB_XGEN(b.x)]) == gen, bar);
            __builtin_amdgcn_fence(__ATOMIC_ACQUIRE, "agent");
            asm volatile("s_waitcnt vmcnt(0)" ::: "memory");
        }
    }
    __syncthreads();
}

__device__ __forceinline__ void xcd_barrier_arrive(const XcdBarrier& b) {
    asm volatile("s_waitcnt vmcnt(0)" ::: "memory");
    __syncthreads();
    if (threadIdx.x == 0) {
        unsigned* bar = b.bar;
        __builtin_amdgcn_s_waitcnt(0);
        unsigned nloc = b.st[0], nx = b.st[1];
        if (nloc == 0u) { xcd_barrier_complete(bar, b.x, nloc, nx); b.st[0] = nloc; b.st[1] = nx; }
        const unsigned old = xb_add(&bar[XB_XSUB(b.x)], 1u);
        const unsigned gen = old / nloc;
        if (old + 1u == (gen + 1u) * nloc) {
            __builtin_amdgcn_fence(__ATOMIC_RELEASE, "agent");
            asm volatile("s_waitcnt vmcnt(0)" ::: "memory");
            const unsigned og = xb_add(&bar[XB_TOP], 1u);
            const unsigned tg = og / nx;
            if (og + 1u == (tg + 1u) * nx) xb_add(&bar[XB_TOPGEN], 1u);
            else XB_SPIN(xb_ld(&bar[XB_TOPGEN]) == tg, bar);
            __builtin_amdgcn_fence(__ATOMIC_ACQUIRE, "agent");
            xb_add(&bar[XB_XGEN(b.x)], 1u);
            asm volatile("s_waitcnt vmcnt(0)" ::: "memory");
            b.st[3] = 0xFFFFFFFFu;
        } else {
            b.st[3] = gen;
        }
    }
    __syncthreads();
}
__device__ __forceinline__ void xcd_barrier_wait(const XcdBarrier& b) {
    __syncthreads();
    if (threadIdx.x == 0) {
        unsigned* bar = b.bar;
        const unsigned gen = b.st[3];
        if (gen != 0xFFFFFFFFu) { XB_SPIN(xb_ld(&bar[XB_XGEN(b.x)]) == gen, bar); }
        __builtin_amdgcn_fence(__ATOMIC_ACQUIRE, "agent");
        asm volatile("s_waitcnt vmcnt(0)" ::: "memory");
    }
    __syncthreads();
}

__device__ __forceinline__ int map_perm32(int n) { return (n & ~31) + (((n & 15) >> 2) * 8) + (((n >> 4) & 1) * 4) + (n & 3); }
__device__ __forceinline__ int map_col(int maptype, int n) {
    if (maptype == 1) {
        const int B = n >> 6, j = (n >> 4) & 3, rho = n & 15;
        return (j & 1) * DFF + B * 32 + (rho >> 2) * 8 + (j >> 1) * 4 + (rho & 3);
    }
    n = map_perm32(n);
    if (maptype == 0) return n;
    if (n < 2112) return n;
    if (n < 2176) { int o = n - 2112; return o < 8 ? 2112 + o : -1; }
    if (n >= 5248) return -1;
    return n - 56;
}
__device__ __forceinline__ void convert_job(const float* __restrict__ src, int ldsrc, int K, int Ndst, int maptype, const float* __restrict__ gain,
                            hf* __restrict__ dst, int lddst, char* smem) {
    float* tile = (float*)smem;
    const int tid = tid_();
    const int nkt = K >> 6, nnt = Ndst >> 6;
    for (int t = bid_(); t < nkt * nnt; t += nblk_()) {
        const int kt = t % nkt, ntile = t / nkt;
        const int k0 = kt * 64, n0 = ntile * 64;
        {
            const int nq = (tid & 15) * 4;
            const int sc = map_col(maptype, n0 + nq);
#pragma unroll
            for (int i = 0; i < 4; ++i) {
                const int k = i * 16 + (tid >> 4);
                f4 v = {0.f, 0.f, 0.f, 0.f};
                if (sc >= 0) v = *(const f4*)(src + (size_t)(k0 + k) * ldsrc + sc);
                if (gain) v = v * gain[k0 + k];
                *(f4*)(tile + k * 68 + (nq ^ ((k >> 3) << 2))) = v;
            }
        }
        __syncthreads();
        {
#pragma unroll
            for (int i = 0; i < 2; ++i) {
                const int q = tid + 256 * i;
                const int n = q >> 3, kg = (q & 7) * 8;
                h8 o;
#pragma unroll
                for (int e = 0; e < 8; ++e) o[e] = (hf)tile[(kg + e) * 68 + (n ^ ((kg >> 3) << 2))];
                *(h8*)(dst + (size_t)(n0 + n) * lddst + k0 + kg) = o;
            }
        }
        __syncthreads();
    }
}

__device__ __forceinline__ void prologue(const Params& p, const Ctx& c, char* smem) {
    const int tid = tid_(), lane = tid & 63, w = tid >> 6;
    for (int l = 0; l < 2; ++l) {
        convert_job(p.ffn1_w_in + (size_t)l * 1024 * 5632, 5632, 1024, 5632, 1, p.ffn1_norm + l * 1024, c.W + OFF_WFI(l * 2 + 0), 1024, smem);
        convert_job(p.ffn2_w_in + (size_t)l * 1024 * 5632, 5632, 1024, 5632, 1, p.ffn2_norm + l * 1024, c.W + OFF_WFI(l * 2 + 1), 1024, smem);
        convert_job(p.ffn1_w_out + (size_t)l * 2816 * 1024, 1024, 2816, 1024, 0, nullptr, c.W + OFF_WFO(l * 2 + 0), 2816, smem);
        convert_job(p.ffn2_w_out + (size_t)l * 2816 * 1024, 1024, 2816, 1024, 0, nullptr, c.W + OFF_WFO(l * 2 + 1), 2816, smem);
    }
    convert_job(p.ev_w_in, 5192, 1024, 5376, 2, p.mix_norm, c.W + OFF_WEI, 1024, smem);
    convert_job(p.ev_w_out, 1024, 1536, 1024, 0, nullptr, c.W + OFF_WEO, 1536, smem);
    convert_job(p.od_w_in, 1280, 1024, 1280, 0, p.mix_norm + 1024, c.W + OFF_WOI, 1024, smem);
    convert_job(p.od_w_out, 1024, 512, 1024, 0, nullptr, c.W + OFF_WOO, 1024, smem);
    for (int it = bid_(); it < 256; it += nblk_()) {
        const int n4 = it * 4;
#pragma unroll 1
        for (int kk = 0; kk < 2; ++kk) {
            const int kp = tid + kk * 256;
            const int g = kp >> 7, i = kp & 127;
            const float* dm = p.od_d_mix + ((size_t)g * 128 + i) * 128;
            const float* ds = p.od_d_scale + g * 128;
            const float* wo = p.od_w_out + (size_t)(512 + g * 128) * 1024 + n4;
            float a0 = 0.f, a1 = 0.f, a2 = 0.f, a3 = 0.f;
#pragma unroll 4
            for (int j = 0; j < 128; ++j) {
                const float m = dm[j] * ds[j];
                const f4 wv = *(const f4*)(wo + (size_t)j * 1024);
                a0 += m * wv[0]; a1 += m * wv[1]; a2 += m * wv[2]; a3 += m * wv[3];
            }
            const int nrow = (n4 & ~31) + (((n4 >> 2) & 1) * 16) + (((n4 & 31) >> 3) * 4);
            hf* d = c.W + OFF_WOO + (size_t)nrow * 1024 + 512 + kp;
            d[0] = (hf)a0; d[1024] = (hf)a1; d[2048] = (hf)a2; d[3072] = (hf)a3;
        }
    }
    for (int it = bid_(); it < TP / 4; it += nblk_()) {
        const int row = it * 4 + w;
        const int b = row / LP, pp = row - b * LP;
        const float* src = nullptr;
        if (pp >= 64) src = p.x + ((size_t)b * 2048 + (pp - 64)) * 1024;
        else if (pp >= 48) src = p.meta + (size_t)(pp - 48) * 1024;
        float ss = 0.f;
        hf* d = c.h16 + (size_t)row * 1024;
#pragma unroll
        for (int k = 0; k < 2; ++k) {
            const int col = k * 512 + lane * 8;
            f4 v0 = {0.f, 0.f, 0.f, 0.f}, v1 = {0.f, 0.f, 0.f, 0.f};
            if (src) { v0 = *(const f4*)(src + col); v1 = *(const f4*)(src + col + 4); }
            h8 o;
#pragma unroll
            for (int r = 0; r < 4; ++r) {
                o[r] = (hf)v0[r]; o[4 + r] = (hf)v1[r];
                const float q0 = (float)o[r], q1 = (float)o[4 + r];
                ss += q0 * q0 + q1 * q1;
            }
            *(h8*)(d + col) = o;
        }
#pragma unroll
        for (int o = 32; o >= 1; o >>= 1) ss += __shfl_xor(ss, o);
        if (lane < 16) c.part[(size_t)row * 16 + lane] = (lane == 0) ? ss : 0.f;
    }
}

__device__ __forceinline__ unsigned dpp_qx1(unsigned v) { return (unsigned)__builtin_amdgcn_update_dpp(0, (int)v, 0xB1, 0xF, 0xF, true); }
__device__ __forceinline__ unsigned dpp_qx2(unsigned v) { return (unsigned)__builtin_amdgcn_update_dpp(0, (int)v, 0x4E, 0xF, 0xF, true); }
__device__ __forceinline__ void quad_transpose(unsigned (&v)[4], int t) {
    {
        const unsigned s0 = (t & 1) ? v[0] : v[1], r0 = dpp_qx1(s0);
        const unsigned s1 = (t & 1) ? v[2] : v[3], r1 = dpp_qx1(s1);
        if (t & 1) { v[0] = r0; v[2] = r1; } else { v[1] = r0; v[3] = r1; }
    }
    {
        const unsigned s0 = (t & 2) ? v[0] : v[2], r0 = dpp_qx2(s0);
        const unsigned s1 = (t & 2) ? v[1] : v[3], r1 = dpp_qx2(s1);
        if (t & 2) { v[0] = r0; v[1] = r1; } else { v[2] = r0; v[3] = r1; }
    }
}
__device__ __forceinline__ unsigned hbits(float x) { const hf h = (hf)x; return (unsigned)__builtin_bit_cast(unsigned short, h); }
__device__ __forceinline__ void store_tr4(unsigned short* base  , int rowoff, int l15, unsigned (&u)[4]) {
    const int t = l15 & 3;
    quad_transpose(u, t);
    uint2 pk; pk.x = u[0] | (u[1] << 16); pk.y = u[2] | (u[3] << 16);
    *(uint2*)(base + (size_t)(rowoff + t) * LP - t) = pk;
}

#define COLO(j) ((((j) >> 1) * 32) + lg * 8 + (((j) & 1) * 4))
enum { EPI_SWIGLU = 0, EPI_RESID = 1, EPI_FINAL = 2, EPI_EVEN = 3, EPI_ODD = 4 };

template <int BM>
__device__ __forceinline__ bool gemm_item(const Ctx& c, int it, int NT, int& mt, int& nt) {
    const int x = c.xcd, slot = c.slot, nslots = c.nslots;
    const int MTT = TP / BM;
    const int base = MTT / 8, rem = MTT % 8;
    const int mb = base + (x < rem ? 1 : 0);
    const int mstart = x * base + (x < rem ? x : rem);
    const int li = it * nslots + slot;
    if (li >= mb * NT) return false;
    const int per_g = 8 * NT;
    const int g = li / per_g, r = li - g * per_g;
    int gsz = mb - g * 8; gsz = gsz > 8 ? 8 : gsz;
    nt = r / gsz;
    mt = mstart + g * 8 + (r - nt * gsz);
    return true;
}

template <int EPI, int MI>
__device__ __forceinline__ void gemm_epilogue(f4 (&acc)[MI][4], float rsl, int m0, int n0, int nt, const Ctx& c, float ep_scale, const float* ep_g1, const float* ep_g2, int wm, int wn, int l15, int lg) {
    if constexpr (EPI == EPI_SWIGLU) {
        hf* act = c.big;
#pragma unroll
        for (int i = 0; i < MI; ++i) {
            const int m = m0 + wm * (MI * 16) + i * 16 + l15;
            const float rs = __shfl(rsl, i * 16 + l15);
            h8 o;
#pragma unroll
            for (int jp = 0; jp < 2; ++jp)
#pragma unroll
                for (int r = 0; r < 4; ++r) {
                    const float g = acc[i][2 * jp][r] * rs, u = acc[i][2 * jp + 1][r] * rs;
                    o[jp * 4 + r] = (hf)(silu_f(g) * u);
                }
            *(h8*)(act + (size_t)m * DFF + (n0 >> 1) + wn * 32 + lg * 8) = o;
        }
    } else if constexpr (EPI == EPI_RESID || EPI == EPI_FINAL) {
#pragma unroll
        for (int i = 0; i < MI; ++i) {
            const int m = m0 + wm * (MI * 16) + i * 16 + l15;
            const int b = m / LP, pp = m - b * LP;
            const bool pad = pp < 48;
            float ss = 0.f;
#pragma unroll
            for (int jp = 0; jp < 2; ++jp) {
                const int col = n0 + wn * 64 + jp * 32 + lg * 8;
                hf* hp = c.h16 + (size_t)m * 1024 + col;
                const h8 old = *(const h8*)hp;
                f4 v0, v1;
#pragma unroll
                for (int r = 0; r < 4; ++r) {
                    v0[r] = (float)old[r] + (pad ? 0.f : ep_scale * acc[i][2 * jp][r]);
                    v1[r] = (float)old[4 + r] + (pad ? 0.f : ep_scale * acc[i][2 * jp + 1][r]);
                }
                if constexpr (EPI == EPI_FINAL) {
                    if (pp >= 64) {
                        float* op = c.out + ((size_t)b * 2048 + (pp - 64)) * 1024 + col;
                        *(f4*)op = v0; *(f4*)(op + 4) = v1;
                    }
                } else {
                    h8 nw;
#pragma unroll
                    for (int r = 0; r < 4; ++r) {
                        nw[r] = (hf)v0[r]; nw[4 + r] = (hf)v1[r];
                        const float q0 = (float)nw[r], q1 = (float)nw[4 + r];
                        ss += q0 * q0 + q1 * q1;
                    }
                    *(h8*)hp = nw;
                }
                __builtin_amdgcn_sched_barrier(0);
            }
            if constexpr (EPI == EPI_RESID) {
                ss += __shfl_xor(ss, 16); ss += __shfl_xor(ss, 32);
                if (lg == 0) c.part[(size_t)m * 16 + nt * 2 + wn] = ss;
            }
        }
    } else if constexpr (EPI == EPI_EVEN) {
        hf* P = c.big;
        const int g = (n0 >> 6) + wn;
        if (g >= 82) return;
        int type, hidx = 0, coff = 0;
        if (g < 8) { type = 0; hidx = g; coff = P_AQ + g * 64; }
        else if (g < 16) { type = 1; hidx = g - 8; coff = P_AK + (g - 8) * 64; }
        else if (g < 24) { type = 2; hidx = g - 16; }
        else if (g < 32) { type = 3; coff = P_IQ + (g - 24) * 64; }
        else if (g == 32) { type = 3; coff = P_IK; }
        else if (g == 33) { type = 3; coff = P_IW; }
        else if (g < 42) { type = 4; hidx = g - 34; coff = P_BQ + (g - 34) * 64; }
        else if (g < 50) { type = 5; hidx = g - 42; coff = P_BK + (g - 42) * 64; }
        else if (g < 66) { type = 6; hidx = g - 50; }
        else { type = 7; coff = P_SBG + (g - 66) * 64; }
        float l2g = 0.f;
        if (type == 5) l2g = __log2f(1.0f - exp2f(-5.0f - (float)hidx));
#pragma unroll
        for (int i = 0; i < MI; ++i) {
            const int m = m0 + wm * (MI * 16) + i * 16 + l15;
            const int b = m / LP, pp = m - b * LP;
            const float rs = __shfl(rsl, i * 16 + l15);
            f4 v[4];
#pragma unroll
            for (int j = 0; j < 4; ++j) v[j] = acc[i][j] * rs;
            if (type == 0 || type == 1) {
                float ss = 0.f;
#pragma unroll
                for (int j = 0; j < 4; ++j)
#pragma unroll
                    for (int r = 0; r < 4; ++r) ss += v[j][r] * v[j][r];
                ss += __shfl_xor(ss, 16); ss += __shfl_xor(ss, 32);
                const float hr = rsqrtf(ss * (1.0f / 64.0f) + 1e-6f) * (type == 0 ? 0.125f : 1.0f);
                const float* gn = (type == 0) ? ep_g1 : ep_g2;
#pragma unroll
                for (int j = 0; j < 4; ++j) {
                    const f4 gv = *(const f4*)(gn + COLO(j));
                    v[j] = v[j] * hr * gv;
                }
            } else if (type == 4 || type == 5) {
                const float pos = (float)(pp - 48);
#pragma unroll
                for (int j = 0; j < 2; ++j)
#pragma unroll
                    for (int r = 0; r < 4; ++r) {
                        const float ang = pos * ROT_INV[COLO(j) + r];
                        const float rv = ang * 0.15915494f;
                        const float er = fmaf(ang, 0.15915494f, -rv) + ang * 1.4069382e-9f;
                        const float fr = (rv - floorf(rv)) + er;
                        const float sn = __builtin_amdgcn_sinf(fr), cs = __builtin_amdgcn_cosf(fr);
                        const float x1 = v[j][r], x2 = v[j + 2][r];
                        v[j][r] = x1 * cs - x2 * sn;
                        v[j + 2][r] = x1 * sn + x2 * cs;
                    }
                if (type == 5) {
#pragma unroll
                    for (int j = 0; j < 4; ++j) v[j] = v[j] * 0.125f;
                    const float dec = exp2f((float)(63 - (pp & 63)) * l2g);
                    unsigned short* kd = (unsigned short*)(c.bkdT + ((size_t)(b * 8 + hidx) * 64) * LP + pp);
#pragma unroll
                    for (int j = 0; j < 4; ++j) {
                        unsigned u[4];
#pragma unroll
                        for (int r = 0; r < 4; ++r) u[r] = hbits(v[j][r] * dec);
                        store_tr4(kd, COLO(j), l15, u);
                    }
                }
            } else if (type == 7) {
#pragma unroll
                for (int j = 0; j < 4; ++j)
#pragma unroll
                    for (int r = 0; r < 4; ++r) v[j][r] = silu_f(v[j][r]);
            }
            if (type == 2) {
                unsigned short* d = (unsigned short*)(c.avT + ((size_t)(b * 8 + hidx) * 64) * LP + pp);
#pragma unroll
                for (int j = 0; j < 4; ++j) {
                    unsigned u[4];
#pragma unroll
                    for (int r = 0; r < 4; ++r) u[r] = f2bf(v[j][r]);
                    store_tr4(d, COLO(j), l15, u);
                }
            } else if (type == 6) {
                unsigned short* d = (unsigned short*)(c.bvT + ((size_t)(b * 8 + (hidx >> 1)) * 128 + (hidx & 1) * 64) * LP + pp);
#pragma unroll
                for (int j = 0; j < 4; ++j) {
                    unsigned u[4];
#pragma unroll
                    for (int r = 0; r < 4; ++r) u[r] = hbits(v[j][r]);
                    store_tr4(d, COLO(j), l15, u);
                }
            } else {
#pragma unroll
                for (int jp = 0; jp < 2; ++jp) {
                    h8 o;
#pragma unroll
                    for (int r = 0; r < 4; ++r) { o[r] = (hf)v[2 * jp][r]; o[4 + r] = (hf)v[2 * jp + 1][r]; }
                    *(h8*)(P + (size_t)m * PLD + coff + jp * 32 + lg * 8) = o;
                }
            }
        }
    } else {
        hf* P2 = c.big;
        const int g = (n0 >> 6) + wn;
        int type, hidx = 0, coff = 0;
        if (g < 8) { type = 0; coff = P2_CQ + g * 64; }
        else if (g < 10) { type = 1; coff = P2_CK + (g - 8) * 64; }
        else if (g < 12) { type = 2; hidx = g - 10; }
        else { type = 3; coff = P2_DX + (g - 12) * 64; }
#pragma unroll
        for (int i = 0; i < MI; ++i) {
            const int m = m0 + wm * (MI * 16) + i * 16 + l15;
            const int b = m / LP, pp = m - b * LP;
            const float rs = __shfl(rsl, i * 16 + l15);
            f4 v[4];
#pragma unroll
            for (int j = 0; j < 4; ++j) v[j] = acc[i][j] * rs;
            if (type == 0 || type == 1) {
                float ss = 0.f;
#pragma unroll
                for (int j = 0; j < 4; ++j)
#pragma unroll
                    for (int r = 0; r < 4; ++r) ss += v[j][r] * v[j][r];
                ss += __shfl_xor(ss, 16); ss += __shfl_xor(ss, 32);
                const float hr = rsqrtf(ss * (1.0f / 64.0f) + 1e-6f) * (type == 0 ? 0.125f : 1.0f);
                const float* gn = (type == 0) ? ep_g1 : ep_g2;
#pragma unroll
                for (int j = 0; j < 4; ++j) {
                    const f4 gv = *(const f4*)(gn + COLO(j));
                    v[j] = v[j] * hr * gv;
                }
            }
            if (type == 2) {
                unsigned short* d = (unsigned short*)(c.cvT + ((size_t)(b * 2 + hidx) * 64) * LP + pp);
#pragma unroll
                for (int j = 0; j < 4; ++j) {
                    unsigned u[4];
#pragma unroll
                    for (int r = 0; r < 4; ++r) u[r] = f2bf(v[j][r]);
                    store_tr4(d, COLO(j), l15, u);
                }
            } else {
#pragma unroll
                for (int jp = 0; jp < 2; ++jp) {
                    h8 o;
#pragma unroll
                    for (int r = 0; r < 4; ++r) { o[r] = (hf)v[2 * jp][r]; o[4 + r] = (hf)v[2 * jp + 1][r]; }
                    *(h8*)(P2 + (size_t)m * P2LD + coff + jp * 32 + lg * 8) = o;
                }
            }
        }
    }
}

template <int EPI, int MI>
__device__ __forceinline__ void gemm_phase(const hf* __restrict__ A, int lda, const hf* __restrict__ Bt, int N, int K, const Ctx& c, float ep_scale, const float* ep_g1, const float* ep_g2, char* smem) {
    constexpr int BM = MI * 32;
    const int tid = tid_(), lane = tid & 63, w = tid >> 6, wm = w >> 1, wn = w & 1, l15 = lane & 15, lg = lane >> 4;
    hf* As = (hf*)smem;
    hf* Bs = As + 2 * 128 * 64;
    const int NT = N >> 7, nk = K >> 6;
    const int lrow = tid >> 3, lcol = (tid & 7) * 8;
    const int gcol = ((tid & 7) ^ ((lrow >> 1) & 7)) * 8;
    const int rc0 = (lg ^ (l15 >> 1)) * 8, rc1 = ((4 + lg) ^ (l15 >> 1)) * 8;
    int mt, nt;
    bool have = gemm_item<BM>(c, 0, NT, mt, nt);
    if (!have) return;
    const hf* Ap = A + (size_t)(mt * BM + lrow) * lda + gcol;
    const hf* Bp = Bt + (size_t)(nt * 128 + lrow) * K + gcol;
    hf* const adst = As + lrow * 64 + lcol;
    hf* const bdst = Bs + lrow * 64 + lcol;
#define GEMM_DMA(LA, LB, STAGE)                                                                                               \
    {                                                                                                                         \
        _Pragma("unroll") for (int i = 0; i < MI; ++i)                                                                        \
            __builtin_amdgcn_global_load_lds((const unsigned*)((LA) + (size_t)(32 * i) * lda),                                \
                                             (unsigned*)(adst + (STAGE) * (128 * 64) + (32 * i) * 64), 16, 0, 0);             \
        _Pragma("unroll") for (int i = 0; i < 4; ++i)                                                                         \
            __builtin_amdgcn_global_load_lds((const unsigned*)((LB) + (size_t)(32 * i) * K),                                  \
                                             (unsigned*)(bdst + (STAGE) * (128 * 64) + (32 * i) * 64), 16, 0, 0);             \
    }
    GEMM_DMA(Ap, Bp, 0)
    __syncthreads();
    for (int it = 0; have; ++it) {
        int mtn, ntn;
        const bool haven = gemm_item<BM>(c, it + 1, NT, mtn, ntn);
        const hf* Apn = haven ? A + (size_t)(mtn * BM + lrow) * lda + gcol : Ap;
        const hf* Bpn = haven ? Bt + (size_t)(ntn * 128 + lrow) * K + gcol : Bp;
        f4 acc[MI][4];
#pragma unroll
        for (int i = 0; i < MI; ++i)
#pragma unroll
            for (int j = 0; j < 4; ++j) acc[i][j] = (f4){0.f, 0.f, 0.f, 0.f};
        f4 pr0, pr1, pr2, pr3;
        float rsl = 0.f;
        constexpr bool NEED_RS = (EPI == EPI_SWIGLU || EPI == EPI_EVEN || EPI == EPI_ODD);
        if constexpr (NEED_RS) {
            const int rl = lane < MI * 16 ? lane : MI * 16 - 1;
            const f4* pp = (const f4*)(c.part + (size_t)(mt * BM + wm * (MI * 16) + rl) * 16);
            pr0 = pp[0]; pr1 = pp[1]; pr2 = pp[2]; pr3 = pp[3];
        }
        for (int ks = 0; ks < nk; ks += 2) {
            if constexpr (NEED_RS) {
                if (ks == 2) {
                    const float sm = (((pr0[0] + pr0[1]) + (pr0[2] + pr0[3])) + ((pr1[0] + pr1[1]) + (pr1[2] + pr1[3]))) +
                                     (((pr2[0] + pr2[1]) + (pr2[2] + pr2[3])) + ((pr3[0] + pr3[1]) + (pr3[2] + pr3[3])));
                    rsl = rsqrtf(sm * (1.0f / 1024.0f) + 1e-6f);
                }
            }
            const bool tail = (ks + 2 >= nk);
            const hf* la1 = Ap + (ks + 1) * 64;
            const hf* lb1 = Bp + (ks + 1) * 64;
            const hf* la2 = tail ? Apn : Ap + (ks + 2) * 64;
            const hf* lb2 = tail ? Bpn : Bp + (ks + 2) * 64;
#pragma unroll
            for (int half = 0; half < 2; ++half) {
                const hf* as = As + half * (128 * 64) + (wm * (MI * 16) + l15) * 64;
                const hf* bs = Bs + half * (128 * 64) + (wn * 64 + l15) * 64;
                h8 af[2][MI], bf[2][4];
#pragma unroll
                for (int kk = 0; kk < 2; ++kk) {
#pragma unroll
                    for (int i = 0; i < MI; ++i) af[kk][i] = *(const h8*)(as + i * 16 * 64 + (kk ? rc1 : rc0));
#pragma unroll
                    for (int i = 0; i < 4; ++i) bf[kk][i] = *(const h8*)(bs + i * 16 * 64 + (kk ? rc1 : rc0));
                }
                __builtin_amdgcn_sched_barrier(0);
                __builtin_amdgcn_s_setprio(1);
#pragma unroll
                for (int i = 0; i < MI; ++i)
#pragma unroll
                    for (int j = 0; j < 4; ++j) acc[i][j] = mfma16(bf[0][j], af[0][i], acc[i][j]);
                __builtin_amdgcn_s_setprio(0);
                __builtin_amdgcn_sched_barrier(0);
                if (half == 0) GEMM_DMA(la1, lb1, 1)
                else GEMM_DMA(la2, lb2, 0)
                __builtin_amdgcn_sched_barrier(0);
                __builtin_amdgcn_s_setprio(1);
#pragma unroll
                for (int i = 0; i < MI; ++i)
#pragma unroll
                    for (int j = 0; j < 4; ++j) acc[i][j] = mfma16(bf[1][j], af[1][i], acc[i][j]);
                __builtin_amdgcn_s_setprio(0);
                __syncthreads();
            }
        }
        gemm_epilogue<EPI, MI>(acc, rsl, mt * BM, nt * 128, nt, c, ep_scale, ep_g1, ep_g2, wm, wn, l15, lg);
        mt = mtn; nt = ntn; Ap = Apn; Bp = Bpn; have = haven;
    }
#undef GEMM_DMA
}

template <int EPI>
__device__ __forceinline__ void gemm_wide(const hf* __restrict__ A, int lda, const hf* __restrict__ Bt, int N, int K, const Ctx& c, float ep_scale, const float* ep_g1, const float* ep_g2, char* smem) {
    const int tid = tid_(), lane = tid & 63, w = tid >> 6, wm = w >> 1, wn = w & 1, l15 = lane & 15, lg = lane >> 4;
    const int NT = N >> 8, nk = K >> 5;
    const int rloc = lane >> 2;
    const int fsw_d = (0x1320 >> (((rloc >> 2) & 3) * 4)) & 3;
    const int gchunk = ((lane & 3) ^ fsw_d) * 8;
    const int fsw_r = (0x1320 >> (((l15 >> 2) & 3) * 4)) & 3;
    const int rpos = (lg ^ fsw_r) * 16;
    char* const ldsb = smem;
    const int dst0 = tid * 16;
    int mt, nt;
    bool have = gemm_item<128>(c, 0, NT, mt, nt);
    if (!have) return;
    const int aoff = (16 * w + rloc) * lda + gchunk, boff = (16 * w + rloc) * K + gchunk;
    const hf* Ap = A + (size_t)(mt * 128) * lda;
    const hf* Bp = Bt + (size_t)(nt * 256) * K;
#define WIDE_DMA(LA, LB, STAGE)                                                                                            \
    {                                                                                                                      \
        char* sb_ = ldsb + (STAGE) * 24576 + dst0;                                                                         \
        _Pragma("unroll") for (int i = 0; i < 2; ++i)                                                                      \
            __builtin_amdgcn_global_load_lds((const unsigned*)(((LA) + (size_t)(64 * i) * lda) + aoff), (unsigned*)(sb_ + i * 4096), 16, 0, 0);          \
        _Pragma("unroll") for (int i = 0; i < 4; ++i)                                                                      \
            __builtin_amdgcn_global_load_lds((const unsigned*)(((LB) + (size_t)(64 * i) * K) + boff), (unsigned*)(sb_ + 8192 + i * 4096), 16, 0, 0);      \
    }
    WIDE_DMA(Ap, Bp, 0)
    WIDE_DMA(Ap + 32, Bp + 32, 1)
    asm volatile("s_waitcnt vmcnt(6)" ::: "memory");
    __builtin_amdgcn_s_barrier();
    asm volatile("" ::: "memory");
    int st = 0;
    for (int it = 0; have; ++it) {
        int mtn, ntn;
        const bool haven = gemm_item<128>(c, it + 1, NT, mtn, ntn);
        const hf* Apn = haven ? A + (size_t)(mtn * 128) * lda : Ap;
        const hf* Bpn = haven ? Bt + (size_t)(ntn * 256) * K : Bp;
        f4 acc0[4][4], acc1[4][4];
#pragma unroll
        for (int i = 0; i < 4; ++i)
#pragma unroll
            for (int j = 0; j < 4; ++j) { acc0[i][j] = (f4){0.f, 0.f, 0.f, 0.f}; acc1[i][j] = (f4){0.f, 0.f, 0.f, 0.f}; }
        float rsl = 0.f;
        for (int ks = 0; ks < nk; ++ks) {
            if (ks == nk - 1) rsl = row_rs(c.part, mt * 128 + wm * 64 + lane);
            const bool tail = (ks + 2 >= nk);
            const hf* la = tail ? Apn + (ks + 2 - nk) * 32 : Ap + (ks + 2) * 32;
            const hf* lb = tail ? Bpn + (ks + 2 - nk) * 32 : Bp + (ks + 2) * 32;
            const int stn = st >= 1 ? st - 1 : 2;
            const char* sa = ldsb + st * 24576 + (wm * 64 + l15) * 64 + rpos;
            const char* sbp = ldsb + st * 24576 + 8192 + (wn * 128 + l15) * 64 + rpos;
            h8 af[4], bf[4];
#pragma unroll
            for (int i = 0; i < 4; ++i) af[i] = *(const h8*)(sa + i * 1024);
#pragma unroll
            for (int j = 0; j < 4; ++j) bf[j] = *(const h8*)(sbp + j * 1024);
            __builtin_amdgcn_sched_barrier(0);
            __builtin_amdgcn_s_setprio(1);
#pragma unroll
            for (int i = 0; i < 4; ++i)
#pragma unroll
                for (int j = 0; j < 4; ++j) acc0[i][j] = mfma16(bf[j], af[i], acc0[i][j]);
            __builtin_amdgcn_s_setprio(0);
            __builtin_amdgcn_sched_barrier(0);
#pragma unroll
            for (int j = 0; j < 4; ++j) bf[j] = *(const h8*)(sbp + (4 + j) * 1024);
            __builtin_amdgcn_sched_barrier(0);
            WIDE_DMA(la, lb, stn)
            __builtin_amdgcn_sched_barrier(0);
            __builtin_amdgcn_s_setprio(1);
#pragma unroll
            for (int i = 0; i < 4; ++i)
#pragma unroll
                for (int j = 0; j < 4; ++j) acc1[i][j] = mfma16(bf[j], af[i], acc1[i][j]);
            __builtin_amdgcn_s_setprio(0);
            __builtin_amdgcn_sched_barrier(0);
            asm volatile("s_waitcnt vmcnt(6)" ::: "memory");
            __builtin_amdgcn_s_barrier();
            asm volatile("" ::: "memory");
            st = st == 2 ? 0 : st + 1;
        }
        gemm_epilogue<EPI, 4>(acc0, rsl, mt * 128, nt * 256 + wn * 128, nt * 2 + wn, c, ep_scale, ep_g1, ep_g2, wm, 0, l15, lg);
        __builtin_amdgcn_sched_barrier(0);
        gemm_epilogue<EPI, 4>(acc1, rsl, mt * 128, nt * 256 + wn * 128, nt * 2 + wn, c, ep_scale, ep_g1, ep_g2, wm, 1, l15, lg);
        mt = mtn; nt = ntn; Ap = Apn; Bp = Bpn; have = haven;
    }
    asm volatile("s_waitcnt vmcnt(0)" ::: "memory");
    __syncthreads();
#undef WIDE_DMA
}

__device__ __forceinline__ unsigned cvt_pk_bf16(float lo, float hi) { unsigned r; asm("v_cvt_pk_bf16_f32 %0, %1, %2" : "=v"(r) : "v"(lo), "v"(hi)); return r; }
typedef unsigned u4 __attribute__((ext_vector_type(4)));

template <int MODE>
__device__ __forceinline__ void attn_wave(const hf* Q, int ldq, const hf* Kb, int ldk, const short* VT, int ntiles, int T_first,
                                          const uint64_t* mrow, float nbl2, float sink_p, hf* O, int ldo, int lane) {
    const int l15 = lane & 15, lg = lane >> 4;
    h8 qf[4][2];
#pragma unroll
    for (int qt = 0; qt < 4; ++qt)
#pragma unroll
        for (int kk = 0; kk < 2; ++kk) qf[qt][kk] = *(const h8*)(Q + (size_t)(qt * 16 + l15) * ldq + kk * 32 + lg * 8);
    f4 ot[4][4];
#pragma unroll
    for (int a = 0; a < 4; ++a)
#pragma unroll
        for (int b = 0; b < 4; ++b) ot[a][b] = (f4){0.f, 0.f, 0.f, 0.f};
    float lsum[4] = {0.f, 0.f, 0.f, 0.f};
    const hf* kbase = Kb + (size_t)((l15 >> 2) * 8 + (l15 & 3)) * ldk + lg * 8;
    const short* vbase = VT + (size_t)((l15 >> 2) * 8 + (l15 & 3)) * LP + lg * 8;
    h8 kfA[2][2], kfB[2][2];
    s8 vfA[4], vfB[4];
    uint64_t mw[4];
#define ATT_TILE(it_) ((MODE == 1) ? ((it_) == 0 ? 0 : T_first + (it_) - 1) : (it_))
#define ATT_LOAD_HALF(KF, VF, T_, HH)                                                                        \
    {                                                                                                        \
        _Pragma("unroll") for (int s2 = 0; s2 < 2; ++s2)                                                     \
            _Pragma("unroll") for (int kk = 0; kk < 2; ++kk)                                                 \
                KF[s2][kk] = *(const h8*)(kbase + (size_t)((T_) * 64 + (HH) * 32 + 4 * s2) * ldk + kk * 32);   \
        _Pragma("unroll") for (int dt = 0; dt < 4; ++dt) {                                                   \
            VF[dt] = *(const s8*)(vbase + (size_t)((dt >> 1) * 32 + (dt & 1) * 4) * LP + (T_) * 64 + (HH) * 32); \
        }                                                                                                    \
    }
#define ATT_LOAD_MASK(MW, T_)                                                                                \
    {                                                                                                        \
        _Pragma("unroll") for (int qt = 0; qt < 4; ++qt) {                                                   \
            if (MODE == 0) MW[qt] = mrow[(size_t)(T_) * LP + qt * 16 + l15];                                 \
            else MW[qt] = ((T_) == 0) ? 0xFFFF000000000000ull : ~0ull;                                       \
        }                                                                                                    \
    }
#define ATT_COMPUTE(KF, VF, HH)                                                                              \
    {                                                                                                        \
        s8 pf[4];                                                                                            \
        _Pragma("unroll") for (int qt = 0; qt < 4; ++qt) {                                                   \
            f4 st0 = {0.f, 0.f, 0.f, 0.f}, st1 = {0.f, 0.f, 0.f, 0.f};                                       \
            st0 = mfma16(KF[0][0], qf[qt][0], st0); st0 = mfma16(KF[0][1], qf[qt][1], st0);                  \
            st1 = mfma16(KF[1][0], qf[qt][0], st1); st1 = mfma16(KF[1][1], qf[qt][1], st1);                  \
            const unsigned bits = (unsigned)(mw[qt] >> ((HH) * 32 + lg * 8));                                \
            float p0[4], p1[4];                                                                              \
            _Pragma("unroll") for (int r = 0; r < 4; ++r) {                                                  \
                p0[r] = __builtin_amdgcn_exp2f(st0[r] * LOG2E + nbl2); p0[r] = ((bits >> r) & 1u) ? p0[r] : 0.f;        \
                p1[r] = __builtin_amdgcn_exp2f(st1[r] * LOG2E + nbl2); p1[r] = ((bits >> (4 + r)) & 1u) ? p1[r] : 0.f;  \
                lsum[qt] += p0[r] + p1[r];                                                                   \
            }                                                                                                \
            u4 pk;                                                                                           \
            pk[0] = cvt_pk_bf16(p0[0], p0[1]); pk[1] = cvt_pk_bf16(p0[2], p0[3]);                            \
            pk[2] = cvt_pk_bf16(p1[0], p1[1]); pk[3] = cvt_pk_bf16(p1[2], p1[3]);                            \
            pf[qt] = __builtin_bit_cast(s8, pk);                                                             \
        }                                                                                                    \
        _Pragma("unroll") for (int dt = 0; dt < 4; ++dt)                                                     \
            _Pragma("unroll") for (int qt = 0; qt < 4; ++qt) ot[dt][qt] = mfma16b(VF[dt], pf[qt], ot[dt][qt]); \
    }
    {
        const int T0 = ATT_TILE(0);
        ATT_LOAD_MASK(mw, T0)
        ATT_LOAD_HALF(kfA, vfA, T0, 0)
    }
    for (int it = 0; it < ntiles; ++it) {
        const int T = ATT_TILE(it);
        const int itn = it + 1 < ntiles ? it + 1 : it;
        const int Tn = ATT_TILE(itn);
        ATT_LOAD_HALF(kfB, vfB, T, 1)
        __builtin_amdgcn_sched_barrier(0);
        ATT_COMPUTE(kfA, vfA, 0)
        __builtin_amdgcn_sched_barrier(0);
        ATT_LOAD_HALF(kfA, vfA, Tn, 0)
        __builtin_amdgcn_sched_barrier(0);
        ATT_COMPUTE(kfB, vfB, 1)
        __builtin_amdgcn_sched_barrier(0);
        ATT_LOAD_MASK(mw, Tn)
    }
#undef ATT_TILE
#undef ATT_LOAD_HALF
#undef ATT_LOAD_MASK
#undef ATT_COMPUTE
#pragma unroll
    for (int qt = 0; qt < 4; ++qt) {
        float l = lsum[qt];
        l += __shfl_xor(l, 16); l += __shfl_xor(l, 32);
        l += sink_p;
        const float inv = l > 0.f ? 1.0f / l : 0.f;
#pragma unroll
        for (int dp = 0; dp < 2; ++dp) {
            h8 o;
#pragma unroll
            for (int r = 0; r < 4; ++r) { o[r] = (hf)(ot[2 * dp][qt][r] * inv); o[4 + r] = (hf)(ot[2 * dp + 1][qt][r] * inv); }
            *(h8*)(O + (size_t)(qt * 16 + l15) * ldo + dp * 32 + lg * 8) = o;
        }
    }
}

__device__ __forceinline__ void e2_item(const Ctx& c, int b, int ch, int qg, char* smem) {
    const int tid = tid_(), lane = tid & 63, w = tid >> 6, l15 = lane & 15, lg = lane >> 4;
    const hf* P = c.big;
    const int qrow0 = b * LP + ch * 64 + qg * 16;
    if (ch <= 3) {
        if (w <= ch && lane < 16) c.mask[((size_t)b * 33 + w) * LP + (qrow0 - b * LP) + lane] = (w == 0) ? 0xFFFF000000000000ull : ~0ull;
        return;
    }
    hf* iqs = (hf*)smem;
    unsigned* cnts = (unsigned*)(smem + 16 * 520 * 2);
#pragma unroll
    for (int i = 0; i < 4; ++i) {
        const int q = tid + 256 * i, row = q >> 6, cc = (q & 63) * 8;
        *(h8*)(iqs + row * 520 + cc) = *(const h8*)(P + (size_t)(qrow0 + row) * PLD + P_IQ + cc);
    }
    float iwf[8];
    {
        const h8 iwv = *(const h8*)(P + (size_t)(qrow0 + l15) * PLD + P_IW);
#pragma unroll
        for (int h = 0; h < 8; ++h) iwf[h] = (float)iwv[h];
    }
    __syncthreads();
    unsigned uk[8][4][4];
    unsigned uk0[4];
    h8 kn0, kn1;
    const hf* kpn;
    {
        const hf* kp = P + (size_t)(b * LP + 48 + l15) * PLD + P_IK + lg * 8;
        kn0 = *(const h8*)kp; kn1 = *(const h8*)(kp + 32);
    }
#define E2_SCORE(KF0, KF1, SC)                                                          \
    {                                                                                   \
        const hf* iqp_ = iqs + l15 * 520 + lg * 8;                                      \
        asm volatile("" : "+v"(iqp_));     \
        _Pragma("unroll") for (int h = 0; h < 8; ++h) {                                 \
            const h8 q0 = *(const h8*)(iqp_ + h * 64);                                  \
            const h8 q1 = *(const h8*)(iqp_ + h * 64 + 32);                             \
            f4 d = {0.f, 0.f, 0.f, 0.f};                                                \
            d = mfma16(KF0, q0, d);                                                     \
            d = mfma16(KF1, q1, d);                                                     \
            _Pragma("unroll") for (int r = 0; r < 4; ++r) SC[r] += iwf[h] * fmaxf(d[r], 0.f); \
            if (h == 3) __builtin_amdgcn_sched_barrier(0);                              \
        }                                                                               \
    }
#define E2_KEY(X) ({ unsigned u_ = __float_as_uint(X); if (u_ == 0x80000000u) u_ = 0u; (u_ & 0x80000000u) ? ~u_ : (u_ | 0x80000000u); })
    {
        const h8 kf0 = kn0, kf1 = kn1;
        kpn = P + (size_t)(b * LP + (1 + w) * 64 + l15) * PLD + P_IK + lg * 8;
        asm volatile("" : "+v"(kpn));
        kn0 = *(const h8*)kpn; kn1 = *(const h8*)(kpn + 32);
        f4 sc = {0.f, 0.f, 0.f, 0.f};
        E2_SCORE(kf0, kf1, sc)
#pragma unroll
        for (int r = 0; r < 4; ++r) { unsigned u = (w == 0) ? E2_KEY(sc[r]) : 0u; asm volatile("" : "+v"(u)); uk0[r] = u; }
        __builtin_amdgcn_sched_barrier(0);
    }
#pragma unroll
    for (int jj = 0; jj < 8; ++jj) {
        const int j = 1 + w + 4 * jj;
        if (j <= ch) {
#pragma unroll
            for (int sub = 0; sub < 4; ++sub) {
                const h8 kf0 = kn0, kf1 = kn1;
                {
                    const int jn = (sub == 3) ? j + 4 : j;
                    kpn += (sub == 3) ? (size_t)208 * PLD : (size_t)16 * PLD;
                    asm volatile("" : "+v"(kpn));
                    if (jn <= ch && (sub < 3 || jj < 7)) { kn0 = *(const h8*)kpn; kn1 = *(const h8*)(kpn + 32); }
                }
                f4 sc = {0.f, 0.f, 0.f, 0.f};
                E2_SCORE(kf0, kf1, sc)
#pragma unroll
                for (int r = 0; r < 4; ++r) { unsigned u = E2_KEY(sc[r]); asm volatile("" : "+v"(u)); uk[jj][sub][r] = u; }
                __builtin_amdgcn_sched_barrier(0);
            }
        } else {
#pragma unroll
            for (int sub = 0; sub < 4; ++sub)
#pragma unroll
                for (int r = 0; r < 4; ++r) uk[jj][sub][r] = 0u;
        }
    }
    unsigned prefix = 0u;
    bool done = false;
    for (int bit = 31; bit >= 0; --bit) {
        const unsigned cand = prefix | (1u << bit);
        int cnt = 0;
#pragma unroll
        for (int r = 0; r < 4; ++r) cnt += (uk0[r] >= cand) ? 1 : 0;
#pragma unroll
        for (int jj = 0; jj < 8; ++jj) {
            if (1 + w + 4 * jj <= ch) {
#pragma unroll
                for (int sub = 0; sub < 4; ++sub)
#pragma unroll
                    for (int r = 0; r < 4; ++r) cnt += (uk[jj][sub][r] >= cand) ? 1 : 0;
            }
        }
        cnt += __shfl_xor(cnt, 16); cnt += __shfl_xor(cnt, 32);
        const int pb = (bit & 1) * 64;
        if (lane < 16) cnts[pb + w * 16 + lane] = (unsigned)cnt;
        __syncthreads();
        const int tot = (int)(cnts[pb + l15] + cnts[pb + 16 + l15] + cnts[pb + 32 + l15] + cnts[pb + 48 + l15]);
        if (!done) {
            if (tot >= 256) prefix = cand;
            if (tot == 256) done = true;
        }
        if (__all(done ? 1 : 0)) break;
    }
#define E2_TOTAL(CNT, PAR)                                                                                   \
    ({                                                                                                       \
        int c_ = (CNT);                                                                                      \
        c_ += __shfl_xor(c_, 16); c_ += __shfl_xor(c_, 32);                                                  \
        const int pb_ = (PAR) * 64;                                                                          \
        if (lane < 16) cnts[pb_ + w * 16 + lane] = (unsigned)c_;                                             \
        __syncthreads();                                                                                     \
        (int)(cnts[pb_ + l15] + cnts[pb_ + 16 + l15] + cnts[pb_ + 32 + l15] + cnts[pb_ + 48 + l15]);         \
    })
    __syncthreads();
    int X = 2112;
    if (!__all(done ? 1 : 0)) {
        int cge = 0, cgt = 0;
#pragma unroll
        for (int r = 0; r < 4; ++r) { cge += (uk0[r] >= prefix) ? 1 : 0; cgt += (uk0[r] > prefix) ? 1 : 0; }
#pragma unroll
        for (int jj = 0; jj < 8; ++jj) {
            if (1 + w + 4 * jj <= ch) {
#pragma unroll
                for (int sub = 0; sub < 4; ++sub)
#pragma unroll
                    for (int r = 0; r < 4; ++r) { cge += (uk[jj][sub][r] >= prefix) ? 1 : 0; cgt += (uk[jj][sub][r] > prefix) ? 1 : 0; }
            }
        }
        const int tot = E2_TOTAL(cge | (cgt << 16), 0);
        const int tge = tot & 0xFFFF, tgt = tot >> 16;
        const int need = 256 - tgt;
        const bool tie = (tge - tgt) > need;
        if (__any(tie ? 1 : 0)) {
            int lo = 0, hi = 2112;
            for (int itb = 0; itb < 12; ++itb) {
                const int mid = (lo + hi) >> 1;
                const int tm = mid - lg * 4;
                const int tmw = tm - w * 64;
                int cq = 0;
#pragma unroll
                for (int r = 0; r < 4; ++r) cq += (uk0[r] == prefix && (48 + r) < tm) ? 1 : 0;
#pragma unroll
                for (int jj = 0; jj < 8; ++jj) {
                    if (1 + w + 4 * jj <= ch) {
#pragma unroll
                        for (int sub = 0; sub < 4; ++sub)
#pragma unroll
                            for (int r = 0; r < 4; ++r)
                                cq += (uk[jj][sub][r] == prefix && ((1 + 4 * jj) * 64 + sub * 16 + r) < tmw) ? 1 : 0;
                    }
                }
                const int t2 = E2_TOTAL(cq, (itb + 1) & 1);
                if (t2 >= need) hi = mid; else lo = mid + 1;
            }
            if (tie) X = hi;
        }
    }
    const int XL = X - lg * 4, XLW = XL - w * 64;
#define E2_SEL(U, IDXC, XB) (((U) > prefix) || ((U) == prefix && (IDXC) < (XB)))
    if (w == 0) {
        unsigned m4 = 0u;
#pragma unroll
        for (int r = 0; r < 4; ++r) m4 |= E2_SEL(uk0[r], 48 + r, XL) ? (1u << r) : 0u;
        unsigned hi = m4 << (16 + lg * 4);
        hi |= __shfl_xor(hi, 16); hi |= __shfl_xor(hi, 32);
        if (lg == 0) c.mask[((size_t)b * 33 + 0) * LP + (qrow0 - b * LP) + l15] = ((uint64_t)hi << 32);
    }
#pragma unroll
    for (int jj = 0; jj < 8; ++jj) {
        const int j = 1 + w + 4 * jj;
        if (j <= ch) {
            unsigned lo = 0u, hi = 0u;
#pragma unroll
            for (int sub = 0; sub < 4; ++sub) {
                unsigned m4 = 0u;
#pragma unroll
                for (int r = 0; r < 4; ++r) m4 |= E2_SEL(uk[jj][sub][r], (1 + 4 * jj) * 64 + sub * 16 + r, XLW) ? (1u << r) : 0u;
                m4 <<= (lg * 4);
                if (sub == 0) lo |= m4; else if (sub == 1) lo |= m4 << 16; else if (sub == 2) hi |= m4; else hi |= m4 << 16;
            }
            lo |= __shfl_xor(lo, 16); lo |= __shfl_xor(lo, 32);
            hi |= __shfl_xor(hi, 16); hi |= __shfl_xor(hi, 32);
            if (lg == 0) c.mask[((size_t)b * 33 + j) * LP + (qrow0 - b * LP) + l15] = ((uint64_t)hi << 32) | (uint64_t)lo;
        }
    }
#undef E2_TOTAL
#undef E2_SEL
#undef E2_SCORE
#undef E2_KEY
}

__device__ __forceinline__ void retention_item(const Ctx& c, int b, int h, char* smem) {
    const int tid = tid_(), lane = tid & 63, w = tid >> 6, l15 = lane & 15, lg = lane >> 4;
    hf* P = c.big;
    const float l2g = __log2f(1.0f - exp2f(-5.0f - (float)h));
    const int prow = (l15 >> 2) * 8 + (l15 & 3);
    const hf* Pb = P + (size_t)b * LP * PLD;
    const hf* KDT = c.bkdT + ((size_t)(b * 8 + h) * 64) * LP;
    const hf* VT = c.bvT + ((size_t)(b * 8 + h) * 128 + w * 32) * LP;
    float* parts = (float*)smem;
    f4 S[4][2];
#pragma unroll
    for (int td = 0; td < 4; ++td)
#pragma unroll
        for (int te = 0; te < 2; ++te) S[td][te] = (f4){0.f, 0.f, 0.f, 0.f};
    const float cdec = exp2f(64.0f * l2g);
    float qdec[4];
#pragma unroll
    for (int ti = 0; ti < 4; ++ti) qdec[ti] = exp2f((float)(ti * 16 + l15 + 1) * l2g);
    for (int n = 0; n < 33; ++n) {
        const int row0 = n * 64;
        h8 qf[4][2];
#pragma unroll
        for (int ti = 0; ti < 4; ++ti)
#pragma unroll
            for (int kk = 0; kk < 2; ++kk) {
                qf[ti][kk] = *(const h8*)(Pb + (size_t)(row0 + ti * 16 + l15) * PLD + P_BQ + h * 64 + kk * 32 + lg * 8);
            }
        f4 out[2][4];
#pragma unroll
        for (int te = 0; te < 2; ++te)
#pragma unroll
            for (int ti = 0; ti < 4; ++ti) out[te][ti] = (f4){0.f, 0.f, 0.f, 0.f};
        if (n > 0) {
            h8 sf[2][2];
#pragma unroll
            for (int tdp = 0; tdp < 2; ++tdp)
#pragma unroll
                for (int te = 0; te < 2; ++te) {
                    h8 t;
#pragma unroll
                    for (int r = 0; r < 4; ++r) { t[r] = (hf)S[2 * tdp][te][r]; t[4 + r] = (hf)S[2 * tdp + 1][te][r]; }
                    sf[tdp][te] = t;
                }
#pragma unroll
            for (int te = 0; te < 2; ++te)
#pragma unroll
                for (int ti = 0; ti < 4; ++ti) {
                    f4 o = {0.f, 0.f, 0.f, 0.f};
                    o = mfma16(sf[0][te], qf[ti][0], o);
                    o = mfma16(sf[1][te], qf[ti][1], o);
                    out[te][ti] = o * qdec[ti];
                }
        }
        h8 vfs[2][2];
#pragma unroll
        for (int tjp = 0; tjp < 2; ++tjp) {
            h8 kf[2][2];
#pragma unroll
            for (int s2 = 0; s2 < 2; ++s2)
#pragma unroll
                for (int kk = 0; kk < 2; ++kk) {
                    kf[s2][kk] = *(const h8*)(Pb + (size_t)(row0 + tjp * 32 + prow + 4 * s2) * PLD + P_BK + h * 64 + kk * 32 + lg * 8);
                }
#pragma unroll
            for (int te = 0; te < 2; ++te) {
                vfs[tjp][te] = *(const h8*)(VT + (size_t)(prow + 4 * te) * LP + row0 + tjp * 32 + lg * 8);
            }
            h8 pf[4];
#pragma unroll
            for (int ti = 0; ti < 4; ++ti) {
                f4 a0 = {0.f, 0.f, 0.f, 0.f}, a1 = {0.f, 0.f, 0.f, 0.f};
                a0 = mfma16(kf[0][0], qf[ti][0], a0); a0 = mfma16(kf[0][1], qf[ti][1], a0);
                a1 = mfma16(kf[1][0], qf[ti][0], a1); a1 = mfma16(kf[1][1], qf[ti][1], a1);
                const int i = ti * 16 + l15;
                h8 t;
#pragma unroll
                for (int r = 0; r < 4; ++r) {
                    const int j0 = tjp * 32 + lg * 8 + r, j1 = j0 + 4;
                    const float d0 = (i >= j0) ? exp2f((float)(i - j0) * l2g) : 0.f;
                    const float d1 = (i >= j1) ? exp2f((float)(i - j1) * l2g) : 0.f;
                    t[r] = (hf)(a0[r] * d0); t[4 + r] = (hf)(a1[r] * d1);
                }
                pf[ti] = t;
            }
#pragma unroll
            for (int te = 0; te < 2; ++te)
#pragma unroll
                for (int ti = 0; ti < 4; ++ti) out[te][ti] = mfma16(vfs[tjp][te], pf[ti], out[te][ti]);
        }
        if (n < 32)
#pragma unroll
        for (int td = 0; td < 4; ++td) {
            h8 kd[2];
#pragma unroll
            for (int tjp = 0; tjp < 2; ++tjp) {
                kd[tjp] = *(const h8*)(KDT + (size_t)((td >> 1) * 32 + prow + 4 * (td & 1)) * LP + row0 + tjp * 32 + lg * 8);
            }
#pragma unroll
            for (int te = 0; te < 2; ++te) {
                f4 s = S[td][te] * cdec;
                s = mfma16(kd[0], vfs[0][te], s);
                s = mfma16(kd[1], vfs[1][te], s);
                S[td][te] = s;
            }
        }
        float ss[4];
#pragma unroll
        for (int ti = 0; ti < 4; ++ti) {
            float a = 0.f;
#pragma unroll
            for (int te = 0; te < 2; ++te)
#pragma unroll
                for (int r = 0; r < 4; ++r) a += out[te][ti][r] * out[te][ti][r];
            a += __shfl_xor(a, 16); a += __shfl_xor(a, 32);
            ss[ti] = a;
        }
        const int pb = (n & 1) * 256;
        if (lg == 0) {
#pragma unroll
            for (int ti = 0; ti < 4; ++ti) parts[pb + w * 64 + ti * 16 + l15] = ss[ti];
        }
        __syncthreads();
#pragma unroll
        for (int ti = 0; ti < 4; ++ti) {
            const int ii = ti * 16 + l15;
            const float tot = (parts[pb + ii] + parts[pb + 64 + ii]) + (parts[pb + 128 + ii] + parts[pb + 192 + ii]);
            const float rsn = rsqrtf(tot * (1.0f / 128.0f) + 1e-6f);
            {
                hf* gp = P + (size_t)(b * LP + row0 + ii) * PLD + P_SBG + h * 128 + w * 32 + lg * 8;
                const h8 gv = *(const h8*)gp;
                h8 o;
#pragma unroll
                for (int r = 0; r < 4; ++r) { o[r] = (hf)(out[0][ti][r] * rsn * (float)gv[r]); o[4 + r] = (hf)(out[1][ti][r] * rsn * (float)gv[4 + r]); }
                *(h8*)gp = o;
            }
        }
    }
    __syncthreads();
}

__device__ __forceinline__ void pool_item(const Ctx& c, int it) {
    hf* P2 = c.big;
    const int tid = tid_();
#pragma unroll 1
    for (int k = 0; k < 8; ++k) {
        const int q = tid + 256 * k;
        const int row = it * 32 + (q >> 6), ch0 = (q & 63) * 8;
        const int pp = row % LP;
        h8 o;
        if (pp < 48) {
#pragma unroll
            for (int e = 0; e < 8; ++e) o[e] = (hf)0.f;
        } else {
            const int wnd = 2 << (ch0 >> 7);
            float a[8];
#pragma unroll
            for (int e = 0; e < 8; ++e) a[e] = 0.f;
            const hf* xp = P2 + (size_t)row * P2LD + P2_DX + ch0;
            const h8 x0 = *(const h8*)xp;
            for (int t = 0; t < wnd; ++t) {
                const h8 v = *(const h8*)(xp - (size_t)t * P2LD);
#pragma unroll
                for (int e = 0; e < 8; ++e) a[e] += (float)v[e];
            }
            int cnt = pp - 47; cnt = cnt < wnd ? cnt : wnd;
            const float ic = 1.0f / (float)cnt;
#pragma unroll
            for (int e = 0; e < 8; ++e) o[e] = (hf)(a[e] * ic - (float)x0[e]);
        }
        *(h8*)(P2 + (size_t)row * P2LD + P2_YD + ch0) = o;
    }
}

__global__ void __launch_bounds__(256, 2) fwd_megakernel(Params p) {
    __shared__ __attribute__((aligned(16))) char smem[SMEM_BYTES];
    __shared__ uint4 xb_words;
    if (threadIdx.x == 0) xb_words = make_uint4(0u, 0u, 0u, 0u);
    __syncthreads();
    XcdBarrier xb = xcd_barrier_post((unsigned*)(p.ws + WS_BAR), (volatile LAS unsigned*)&xb_words);
    {
        unsigned* sl = (unsigned*)(p.ws + WS_SLOT);
        if (threadIdx.x == 0) { volatile LAS unsigned* st = (volatile LAS unsigned*)&xb_words; st[2] = xb_add(&sl[xb.x * 64], 1u); }
    }
    Ctx c;
    c.W = (hf*)p.ws;
    c.h16 = (hf*)(p.ws + WS_H16);
    c.part = (float*)(p.ws + WS_PART);
    c.bkdT = (hf*)(p.ws + WS_BKDT);
    c.big = (hf*)(p.ws + WS_BIG);
    char* dob = (char*)p.out;
    c.avT = (short*)(dob + DO_AVT);
    c.bvT = (hf*)(dob + DO_BVT);
    c.mask = (uint64_t*)(dob + DO_MASK);
    c.cvT = (short*)(dob + DO_CVT);
    c.out = p.out;
    c.xcd = blockIdx.x & 7; c.slot = blockIdx.x >> 3; c.nslots = gridDim.x >> 3;
#pragma unroll 1
    for (int ph = 0; ph < 16; ++ph) {
        int kind;
        switch (ph) {
            case 0: kind = 0; break;
            case 1: case 7: case 9: case 14: kind = 1; break;
            case 2: case 6: case 8: case 10: case 13: kind = 2; break;
            case 3: kind = 3; break;
            case 4: kind = 4; break;
            case 5: kind = 5; break;
            case 11: kind = 6; break;
            case 12: kind = 7; break;
            default: kind = 8; break;
        }
        if (kind == 0) {
            prologue(p, c, smem);
        } else if (kind == 1) {
            const int wi = (ph == 1) ? 0 : (ph == 7) ? 1 : (ph == 9) ? 2 : 3;
            gemm_wide<EPI_SWIGLU>(c.h16, 1024, c.W + OFF_WFI(wi), 5632, 1024, c, 0.f, nullptr, nullptr, smem);
        } else if (kind == 2) {
            const hf* Bt; int lda, K; float scale;
            if (ph == 6) { Bt = c.W + OFF_WEO; lda = PLD; K = 1536; scale = 1.0f; }
            else if (ph == 13) { Bt = c.W + OFF_WOO; lda = P2LD; K = 1024; scale = 1.0f; }
            else { const int wi = (ph == 2) ? 0 : (ph == 8) ? 1 : 2; Bt = c.W + OFF_WFO(wi); lda = DFF; K = DFF; scale = 0.5f; }
            gemm_phase<EPI_RESID, 3>(c.big, lda, Bt, 1024, K, c, scale, nullptr, nullptr, smem);
        } else if (kind == 3) {
            gemm_phase<EPI_EVEN, 4>(c.h16, 1024, c.W + OFF_WEI, 5248, 1024, c, 0.f, p.ev_a_q_norm, p.ev_a_k_norm, smem);
        } else if (kind == 4) {
            if (bid_() < 64) {
                xcd_barrier_arrive(xb);
                retention_item(c, bid_() >> 3, bid_() & 7, smem);
            } else {
                const int nb = nblk_() - 64, me = bid_() - 64;
                for (int rnd = 0; rnd * nb < 33 * 32; ++rnd) {
                    const int idx = rnd * nb + ((rnd & 1) ? (nb - 1 - me) : me);
                    if (idx < 33 * 32) {
                        const int ch = 32 - idx / 32, rem = idx % 32;
                        e2_item(c, rem >> 2, ch, rem & 3, smem);
                    }
                    __syncthreads();
                }
            }
        } else if (kind == 5) {
            const int tid = tid_(), lane = tid & 63, w = tid >> 6;
            const float gq = wave_maxabs64(p.ev_a_q_norm, lane), gk = wave_maxabs64(p.ev_a_k_norm, lane);
            const float nbl2 = -(8.0f * gq * gk) * LOG2E;
            if (bid_() < 64) xcd_barrier_wait(xb);
            else
            for (int idx = bid_() - 64; idx < 33 * 16; idx += nblk_() - 64) {
                const int ch = 32 - idx / 16, rem = idx % 16;
                const int b = rem >> 1, hg = rem & 1, h = hg * 4 + w;
                hf* Q = c.big + (size_t)(b * LP + ch * 64) * PLD + P_AQ + h * 64;
                const hf* Kb = c.big + (size_t)(b * LP) * PLD + P_AK + h * 64;
                const short* VT = c.avT + ((size_t)(b * 8 + h) * 64) * LP;
                const uint64_t* mrow = c.mask + (size_t)b * 33 * LP + ch * 64;
                attn_wave<0>(Q, PLD, Kb, PLD, VT, ch + 1, 0, mrow, nbl2, 0.f, Q, PLD, lane);
            }
        } else if (kind == 6) {
            gemm_phase<EPI_ODD, 4>(c.h16, 1024, c.W + OFF_WOI, 1280, 1024, c, 0.f, p.od_c_q_norm, p.od_c_k_norm, smem);
        } else if (kind == 7) {
            const int tid = tid_(), lane = tid & 63, w = tid >> 6;
            const float gq = wave_maxabs64(p.od_c_q_norm, lane), gk = wave_maxabs64(p.od_c_k_norm, lane);
            float smax = p.od_c_sinks[lane & 7];
#pragma unroll
            for (int o = 4; o >= 1; o >>= 1) smax = fmaxf(smax, __shfl_xor(smax, o));
            const float bound = fmaxf(8.0f * gq * gk, smax);
            const float nbl2 = -bound * LOG2E;
            for (int idx = bid_(); idx < 528 + 528; idx += nblk_()) {
                if (idx < 528) {
                    const int n = idx / 16, rem = idx % 16;
                    const int b = rem >> 1, g = rem & 1, h = g * 4 + w;
                    hf* Q = c.big + (size_t)(b * LP + n * 64) * P2LD + P2_CQ + h * 64;
                    const hf* Kb = c.big + (size_t)(b * LP) * P2LD + P2_CK + g * 64;
                    const short* VT = c.cvT + ((size_t)(b * 2 + g) * 64) * LP;
                    const int T_first = n - 2 > 1 ? n - 2 : 1;
                    const int nband = n >= T_first ? n - T_first + 1 : 0;
                    const float sink_p = exp2f(p.od_c_sinks[h] * LOG2E + nbl2);
                    attn_wave<1>(Q, P2LD, Kb, P2LD, VT, 1 + nband, T_first, nullptr, nbl2, sink_p, Q, P2LD, lane);
                } else {
                    pool_item(c, idx - 528);
                }
            }
        } else {
            gemm_phase<EPI_FINAL, 3>(c.big, DFF, c.W + OFF_WFO(3), 1024, DFF, c, 0.5f, nullptr, nullptr, smem);
        }
        if (ph < 15 && !(ph == 4 && bid_() < 64)) xcd_barrier(xb);
        if (ph == 0) {
            volatile LAS unsigned* st = (volatile LAS unsigned*)&xb_words;
            const unsigned nloc = __builtin_amdgcn_readfirstlane(st[0]), nx = __builtin_amdgcn_readfirstlane(st[1]);
            if (nx == 8u && nloc * 8u == gridDim.x && xb.x < 8u) { c.xcd = __builtin_amdgcn_readfirstlane((int)xb.x); c.slot = __builtin_amdgcn_readfirstlane((int)st[2]); c.nslots = __builtin_amdgcn_readfirstlane((int)nloc); }
        }
    }
}

extern "C" void kernel_launch(void* const* d_in, const int* in_sizes, int n_in, void* d_out, int out_size, void* d_ws, size_t ws_size,
                              hipStream_t stream) {
    static int grid_blocks = 0;
    if (!grid_blocks) {
        int dev = 0, cus = 0, per_cu = 0;
        hipGetDevice(&dev);
        hipDeviceGetAttribute(&cus, hipDeviceAttributeMultiprocessorCount, dev);
        hipOccupancyMaxActiveBlocksPerMultiprocessor(&per_cu, fwd_megakernel, 256, 0);
        if (per_cu > 2) per_cu = 2;
        if (per_cu < 1) per_cu = 1;
        grid_blocks = cus * per_cu;
    }
    if (ws_size < WS_END) { fprintf(stderr, "workspace too small: %zu < %zu\n", ws_size, (size_t)WS_END); return; }
    Params p{};
    p.x = (const float*)d_in[0]; p.meta = (const float*)d_in[1]; p.ffn1_norm = (const float*)d_in[2];
    p.ffn1_w_in = (const float*)d_in[3]; p.ffn1_w_out = (const float*)d_in[4]; p.mix_norm = (const float*)d_in[5];
    p.ffn2_norm = (const float*)d_in[6]; p.ffn2_w_in = (const float*)d_in[7]; p.ffn2_w_out = (const float*)d_in[8];
    p.ev_w_in = (const float*)d_in[9]; p.ev_a_q_norm = (const float*)d_in[10]; p.ev_a_k_norm = (const float*)d_in[11];
    p.ev_w_out = (const float*)d_in[12]; p.od_w_in = (const float*)d_in[13]; p.od_c_q_norm = (const float*)d_in[14];
    p.od_c_k_norm = (const float*)d_in[15]; p.od_c_sinks = (const float*)d_in[16]; p.od_d_mix = (const float*)d_in[17];
    p.od_d_scale = (const float*)d_in[18]; p.od_w_out = (const float*)d_in[19];
    p.out = (float*)d_out; p.ws = (char*)d_ws;
    hipMemsetAsync((char*)d_ws + WS_BAR, 0, 16384 + 4096, stream);
    void* args[] = {&p};
    hipError_t e = hipLaunchCooperativeKernel((void*)fwd_megakernel, dim3(grid_blocks), dim3(256), args, 0, stream);
    if (e != hipSuccess) fprintf(stderr, "cooperative launch failed: %s (grid %d)\n", hipGetErrorString(e), grid_blocks);
}
```

```cpp
#include <hip/hip_runtime.h>
#include <hip/hip_cooperative_groups.h>
#include <stdint.h>
#include <stdio.h>
namespace cg = cooperative_groups;

typedef _Float16 hf;
typedef _Float16 h8 __attribute__((ext_vector_type(8)));
typedef _Float16 h4 __attribute__((ext_vector_type(4)));
typedef short s8 __attribute__((ext_vector_type(8)));
typedef short s4 __attribute__((ext_vector_type(4)));
typedef float f4 __attribute__((ext_vector_type(4)));

#define NB 8
#define LP 2112
#define TP 16896
#define DM 1024
#define DFF 2816
#define PLD 3712
#define P_AQ 0
#define P_SBG 512
#define P_AK 1536
#define P_IQ 2048
#define P_IK 2560
#define P_IW 2624
#define P_BQ 2688
#define P_BK 3200
#define P2LD 1664
#define P2_CQ 0
#define P2_YD 512
#define P2_CK 1024
#define P2_DX 1152
#define LOG2E 1.4426950408889634f
#define SMEM_BYTES 73728

#define W_FFN_IN ((size_t)5632 * 1024)
#define W_FFN_OUT ((size_t)1024 * 2816)
#define OFF_WFI(i) ((size_t)(i) * W_FFN_IN)
#define OFF_WFO(i) (4 * W_FFN_IN + (size_t)(i) * W_FFN_OUT)
#define OFF_WEI (4 * W_FFN_IN + 4 * W_FFN_OUT)
#define OFF_WEO (OFF_WEI + (size_t)5376 * 1024)
#define OFF_WOI (OFF_WEO + (size_t)1024 * 1536)
#define OFF_WOO (OFF_WOI + (size_t)1280 * 1024)
#define W_TOTAL (OFF_WOO + (size_t)1024 * 1024)
#define WS_H16 (W_TOTAL * 2)
#define WS_PART (WS_H16 + (size_t)TP * 1024 * 2)
#define WS_BKDT (WS_PART + (size_t)TP * 16 * 4)
#define WS_BIG (WS_BKDT + (size_t)TP * 512 * 2)
#define WS_BAR (WS_BIG + (size_t)TP * PLD * 2)
#define WS_SLOT (WS_BAR + 16384)
#define WS_END (WS_SLOT + 4096)
#define DO_AVT ((size_t)0)
#define DO_BVT ((size_t)TP * 512 * 2)
#define DO_MASK (DO_BVT + (size_t)TP * 1024 * 2)
#define DO_CVT (DO_MASK + (size_t)TP * 33 * 8)

__constant__ float ROT_INV[32] = {
    1.000000000e+00f, 7.498942018e-01f, 5.623413324e-01f, 4.216965139e-01f, 3.162277639e-01f, 2.371373922e-01f,
    1.778279394e-01f, 1.333521456e-01f, 1.000000015e-01f, 7.498941571e-02f, 5.623412877e-02f, 4.216964915e-02f,
    3.162277862e-02f, 2.371373586e-02f, 1.778279431e-02f, 1.333521493e-02f, 9.999999776e-03f, 7.498942316e-03f,
    5.623413250e-03f, 4.216964822e-03f, 3.162277862e-03f, 2.371373819e-03f, 1.778279431e-03f, 1.333521446e-03f,
    1.000000047e-03f, 7.498941850e-04f, 5.623413017e-04f, 4.216965463e-04f, 3.162277862e-04f, 2.371373848e-04f,
    1.778279402e-04f, 1.333521504e-04f};

struct Params {
    const float* x; const float* meta; const float* ffn1_norm; const float* ffn1_w_in; const float* ffn1_w_out;
    const float* mix_norm; const float* ffn2_norm; const float* ffn2_w_in; const float* ffn2_w_out;
    const float* ev_w_in; const float* ev_a_q_norm; const float* ev_a_k_norm; const float* ev_w_out;
    const float* od_w_in; const float* od_c_q_norm; const float* od_c_k_norm; const float* od_c_sinks;
    const float* od_d_mix; const float* od_d_scale; const float* od_w_out;
    float* out; char* ws;
};

struct Ctx {
    hf* W; hf* h16; float* part; hf* bkdT; hf* big;
    short* avT; hf* bvT; uint64_t* mask; short* cvT; float* out;
    int xcd, slot, nslots;
};

__device__ __forceinline__ int tid_() { int t = threadIdx.x; asm volatile("" : "+v"(t)); return t; }
__device__ __forceinline__ int bid_() { int b = blockIdx.x; asm volatile("" : "+s"(b)); return b; }
__device__ __forceinline__ int nblk_() { int b = gridDim.x; asm volatile("" : "+s"(b)); return b; }
__device__ __forceinline__ f4 mfma16(h8 a, h8 b, f4 c) { return __builtin_amdgcn_mfma_f32_16x16x32_f16(a, b, c, 0, 0, 0); }
__device__ __forceinline__ f4 mfma16b(s8 a, s8 b, f4 c) { return __builtin_amdgcn_mfma_f32_16x16x32_bf16(a, b, c, 0, 0, 0); }
__device__ __forceinline__ unsigned short f2bf(float f) {
    unsigned u = __float_as_uint(f);
    u += 0x7FFFu + ((u >> 16) & 1u);
    return (unsigned short)(u >> 16);
}
__device__ __forceinline__ float silu_f(float x) { return x * __builtin_amdgcn_rcpf(1.0f + __builtin_amdgcn_exp2f(-x * LOG2E)); }
__device__ __forceinline__ float row_rs(const float* part, int m) {
    const f4* p = (const f4*)(part + (size_t)m * 16);
    f4 a = p[0], b = p[1], c = p[2], d = p[3];
    float s = (((a[0] + a[1]) + (a[2] + a[3])) + ((b[0] + b[1]) + (b[2] + b[3]))) +
              (((c[0] + c[1]) + (c[2] + c[3])) + ((d[0] + d[1]) + (d[2] + d[3])));
    return rsqrtf(s * (1.0f / 1024.0f) + 1e-6f);
}
__device__ __forceinline__ float wave_maxabs64(const float* g, int lane) {
    float v = fabsf(g[lane]);
#pragma unroll
    for (int o = 32; o >= 1; o >>= 1) v = fmaxf(v, __shfl_xor(v, o));
    return v;
}
__device__ __forceinline__ h8 cat44(h4 a, h4 b) {
    h8 r; r[0] = a[0]; r[1] = a[1]; r[2] = a[2]; r[3] = a[3]; r[4] = b[0]; r[5] = b[1]; r[6] = b[2]; r[7] = b[3]; return r;
}
__device__ __forceinline__ s8 cat44s(s4 a, s4 b) {
    s8 r; r[0] = a[0]; r[1] = a[1]; r[2] = a[2]; r[3] = a[3]; r[4] = b[0]; r[5] = b[1]; r[6] = b[2]; r[7] = b[3]; return r;
}


#define XB_TMO      128
#define XB_XCNT(j)  (256  + 64 * (j))
#define XB_XSUB(j)  (1280 + 64 * (j))
#define XB_XGEN(j)  (2304 + 64 * (j))
#define XB_TOP      3328
#define XB_TOPGEN   3392
#define XCD_BAR_WORDS 3456
#define XB_SPIN_CAP (1u << 18)
#define LAS __attribute__((address_space(3)))
__device__ __forceinline__ unsigned xb_ld(unsigned* p)              { return __hip_atomic_load(p, __ATOMIC_RELAXED, __HIP_MEMORY_SCOPE_AGENT); }
__device__ __forceinline__ unsigned xb_add(unsigned* p, unsigned v) { return __hip_atomic_fetch_add(p, v, __ATOMIC_RELAXED, __HIP_MEMORY_SCOPE_AGENT); }
__device__ __forceinline__ unsigned xb_xcc_id() { return (unsigned)__builtin_amdgcn_s_getreg((3 << 11) | 20) & 0xFu; }
#define XB_SPIN(cond, bar) do { unsigned _sp = 0; while (cond) { __builtin_amdgcn_s_sleep(1); \
    if ((++_sp & 255u) == 0u) { if (xb_ld(&(bar)[XB_TMO])) break; if (_sp > XB_SPIN_CAP) { atomicAdd(&(bar)[XB_TMO], 1u); break; } } } } while (0)
struct XcdBarrier { unsigned* bar; unsigned x; volatile LAS unsigned* st; };
__device__ __forceinline__ XcdBarrier xcd_barrier_post(unsigned* bar, volatile LAS unsigned* st) {
    XcdBarrier b; b.bar = bar; b.x = xb_xcc_id(); b.st = st;
    if (threadIdx.x == 0) (void)xb_add(&bar[XB_XCNT(b.x)], 1u);
    return b;
}
__device__ __forceinline__ void xcd_barrier_complete(unsigned* bar, unsigned x, unsigned& nloc, unsigned& nx) {
    const unsigned G = gridDim.x * gridDim.y * gridDim.z;
    unsigned sum, cnt, mine, sp = 0u;
    for (;;) {
        sum = 0u; cnt = 0u; mine = 0u;
#pragma unroll
        for (unsigned j = 0; j < 16; ++j) { const unsigned c = xb_ld(&bar[XB_XCNT(j)]); sum += c; cnt += (c > 0u) ? 1u : 0u; mine = (j == x) ? c : mine; }
        if (sum == G) break;
        __builtin_amdgcn_s_sleep(1);
        if ((++sp & 255u) == 0u) { if (xb_ld(&bar[XB_TMO])) break; if (sp > XB_SPIN_CAP) { atomicAdd(&bar[XB_TMO], 1u); break; } }
    }
    nloc = mine > 0u ? mine : 1u; nx = cnt > 0u ? cnt : 1u;
}
__device__ __forceinline__ void xcd_barrier(const XcdBarrier& b) {
    asm volatile("s_waitcnt vmcnt(0)" ::: "memory");
    __syncthreads();
    if (threadIdx.x == 0) {
        unsigned* bar = b.bar;
        __builtin_amdgcn_s_waitcnt(0);
        unsigned nloc = b.st[0], nx = b.st[1];
        if (nloc == 0u) { xcd_barrier_complete(bar, b.x, nloc, nx); b.st[0] = nloc; b.st[1] = nx; }
        const unsigned old = xb_add(&bar[XB_XSUB(b.x)], 1u);
        const unsigned gen = old / nloc;
        if (old + 1u == (gen + 1u) * nloc) {
            __builtin_amdgcn_fence(__ATOMIC_RELEASE, "agent");
            asm volatile("s_waitcnt vmcnt(0)" ::: "memory");
            const unsigned og = xb_add(&bar[XB_TOP], 1u);
            const unsigned tg = og / nx;
            if (og + 1u == (tg + 1u) * nx) xb_add(&bar[XB_TOPGEN], 1u);
            else XB_SPIN(xb_ld(&bar[XB_TOPGEN]) == tg, bar);
            __builtin_amdgcn_fence(__ATOMIC_ACQUIRE, "agent");
            xb_add(&bar[XB_XGEN(b.x)], 1u);
            asm volatile("s_waitcnt vmcnt(0)" ::: "memory");
        } else {
            XB_SPIN(xb_ld(&bar[XB_XGEN(b.x)]) == gen, bar);
            __builtin_amdgcn_fence(__ATOMIC_ACQUIRE, "agent");
            asm volatile("s_waitcnt vmcnt(0)" ::: "memory");
        }
    }
    __syncthreads();
}

__device__ __forceinline__ void xcd_barrier_arrive(const XcdBarrier& b) {
    asm volatile("s_waitcnt vmcnt(0)" ::: "memory");
    __syncthreads();
    if (threadIdx.x == 0) {
        unsigned* bar = b.bar;
        __builtin_amdgcn_s_waitcnt(0);
        unsigned nloc = b.st[0], nx = b.st[1];
        if (nloc == 0u) { xcd_barrier_complete(bar, b.x, nloc, nx); b.st[0] = nloc; b.st[1] = nx; }
        const unsigned old = xb_add(&bar[XB_XSUB(b.x)], 1u);
        const unsigned gen = old / nloc;
        if (old + 1u == (gen + 1u) * nloc) {
            __builtin_amdgcn_fence(__ATOMIC_RELEASE, "agent");
            asm volatile("s_waitcnt vmcnt(0)" ::: "memory");
            const unsigned og = xb_add(&bar[XB_TOP], 1u);
            const unsigned tg = og / nx;
            if (og + 1u == (tg + 1u) * nx) xb_add(&bar[XB_TOPGEN], 1u);
            else XB_SPIN(xb_ld(&bar[XB_TOPGEN]) == tg, bar);
            __builtin_amdgcn_fence(__ATOMIC_ACQUIRE, "agent");
            xb_add(&bar[XB_XGEN(b.x)], 1u);
            asm volatile("s_waitcnt vmcnt(0)" ::: "memory");
            b.st[3] = 0xFFFFFFFFu;
        } else {
            b.st[3] = gen;
        }
    }
    __syncthreads();
}
__device__ __forceinline__ void xcd_barrier_wait(const XcdBarrier& b) {
    __syncthreads();
    if (threadIdx.x == 0) {
        unsigned* bar = b.bar;
        const unsigned gen = b.st[3];
        if (gen != 0xFFFFFFFFu) { XB_SPIN(xb_ld(&bar[XB_XGEN(b.x)]) == gen, bar); }
        __builtin_amdgcn_fence(__ATOMIC_ACQUIRE, "agent");
        asm volatile("s_waitcnt vmcnt(0)" ::: "memory");
    }
    __syncthreads();
}

__device__ __forceinline__ int map_perm32(int n) { return (n & ~31) + (((n & 15) >> 2) * 8) + (((n >> 4) & 1) * 4) + (n & 3); }
__device__ __forceinline__ int map_col(int maptype, int n) {
    if (maptype == 1) {
        const int B = n >> 6, j = (n >> 4) & 3, rho = n & 15;
        return (j & 1) * DFF + B * 32 + (rho >> 2) * 8 + (j >> 1) * 4 + (rho & 3);
    }
    n = map_perm32(n);
    if (maptype == 0) return n;
    if (n < 2112) return n;
    if (n < 2176) { int o = n - 2112; return o < 8 ? 2112 + o : -1; }
    if (n >= 5248) return -1;
    return n - 56;
}
__device__ __forceinline__ void convert_job(const float* __restrict__ src, int ldsrc, int K, int Ndst, int maptype, const float* __restrict__ gain,
                            hf* __restrict__ dst, int lddst, char* smem) {
    float* tile = (float*)smem;
    const int tid = tid_();
    const int nkt = K >> 6, nnt = Ndst >> 6;
    for (int t = bid_(); t < nkt * nnt; t += nblk_()) {
        const int kt = t % nkt, ntile = t / nkt;
        const int k0 = kt * 64, n0 = ntile * 64;
        {
            const int nq = (tid & 15) * 4;
            const int sc = map_col(maptype, n0 + nq);
#pragma unroll
            for (int i = 0; i < 4; ++i) {
                const int k = i * 16 + (tid >> 4);
                f4 v = {0.f, 0.f, 0.f, 0.f};
                if (sc >= 0) v = *(const f4*)(src + (size_t)(k0 + k) * ldsrc + sc);
                if (gain) v = v * gain[k0 + k];
                *(f4*)(tile + k * 68 + (nq ^ ((k >> 3) << 2))) = v;
            }
        }
        __syncthreads();
        {
#pragma unroll
            for (int i = 0; i < 2; ++i) {
                const int q = tid + 256 * i;
                const int n = q >> 3, kg = (q & 7) * 8;
                h8 o;
#pragma unroll
                for (int e = 0; e < 8; ++e) o[e] = (hf)tile[(kg + e) * 68 + (n ^ ((kg >> 3) << 2))];
                *(h8*)(dst + (size_t)(n0 + n) * lddst + k0 + kg) = o;
            }
        }
        __syncthreads();
    }
}

__device__ __forceinline__ void prologue(const Params& p, const Ctx& c, char* smem) {
    const int tid = tid_(), lane = tid & 63, w = tid >> 6;
    for (int l = 0; l < 2; ++l) {
        convert_job(p.ffn1_w_in + (size_t)l * 1024 * 5632, 5632, 1024, 5632, 1, p.ffn1_norm + l * 1024, c.W + OFF_WFI(l * 2 + 0), 1024, smem);
        convert_job(p.ffn2_w_in + (size_t)l * 1024 * 5632, 5632, 1024, 5632, 1, p.ffn2_norm + l * 1024, c.W + OFF_WFI(l * 2 + 1), 1024, smem);
        convert_job(p.ffn1_w_out + (size_t)l * 2816 * 1024, 1024, 2816, 1024, 0, nullptr, c.W + OFF_WFO(l * 2 + 0), 2816, smem);
        convert_job(p.ffn2_w_out + (size_t)l * 2816 * 1024, 1024, 2816, 1024, 0, nullptr, c.W + OFF_WFO(l * 2 + 1), 2816, smem);
    }
    convert_job(p.ev_w_in, 5192, 1024, 5376, 2, p.mix_norm, c.W + OFF_WEI, 1024, smem);
    convert_job(p.ev_w_out, 1024, 1536, 1024, 0, nullptr, c.W + OFF_WEO, 1536, smem);
    convert_job(p.od_w_in, 1280, 1024, 1280, 0, p.mix_norm + 1024, c.W + OFF_WOI, 1024, smem);
    convert_job(p.od_w_out, 1024, 512, 1024, 0, nullptr, c.W + OFF_WOO, 1024, smem);
    for (int it = bid_(); it < 256; it += nblk_()) {
        const int n4 = it * 4;
#pragma unroll 1
        for (int kk = 0; kk < 2; ++kk) {
            const int kp = tid + kk * 256;
            const int g = kp >> 7, i = kp & 127;
            const float* dm = p.od_d_mix + ((size_t)g * 128 + i) * 128;
            const float* ds = p.od_d_scale + g * 128;
            const float* wo = p.od_w_out + (size_t)(512 + g * 128) * 1024 + n4;
            float a0 = 0.f, a1 = 0.f, a2 = 0.f, a3 = 0.f;
#pragma unroll 4
            for (int j = 0; j < 128; ++j) {
                const float m = dm[j] * ds[j];
                const f4 wv = *(const f4*)(wo + (size_t)j * 1024);
                a0 += m * wv[0]; a1 += m * wv[1]; a2 += m * wv[2]; a3 += m * wv[3];
            }
            const int nrow = (n4 & ~31) + (((n4 >> 2) & 1) * 16) + (((n4 & 31) >> 3) * 4);
            hf* d = c.W + OFF_WOO + (size_t)nrow * 1024 + 512 + kp;
            d[0] = (hf)a0; d[1024] = (hf)a1; d[2048] = (hf)a2; d[3072] = (hf)a3;
        }
    }
    for (int it = bid_(); it < TP / 4; it += nblk_()) {
        const int row = it * 4 + w;
        const int b = row / LP, pp = row - b * LP;
        const float* src = nullptr;
        if (pp >= 64) src = p.x + ((size_t)b * 2048 + (pp - 64)) * 1024;
        else if (pp >= 48) src = p.meta + (size_t)(pp - 48) * 1024;
        float ss = 0.f;
        hf* d = c.h16 + (size_t)row * 1024;
#pragma unroll
        for (int k = 0; k < 2; ++k) {
            const int col = k * 512 + lane * 8;
            f4 v0 = {0.f, 0.f, 0.f, 0.f}, v1 = {0.f, 0.f, 0.f, 0.f};
            if (src) { v0 = *(const f4*)(src + col); v1 = *(const f4*)(src + col + 4); }
            h8 o;
#pragma unroll
            for (int r = 0; r < 4; ++r) {
                o[r] = (hf)v0[r]; o[4 + r] = (hf)v1[r];
                const float q0 = (float)o[r], q1 = (float)o[4 + r];
                ss += q0 * q0 + q1 * q1;
            }
            *(h8*)(d + col) = o;
        }
#pragma unroll
        for (int o = 32; o >= 1; o >>= 1) ss += __shfl_xor(ss, o);
        if (lane < 16) c.part[(size_t)row * 16 + lane] = (lane == 0) ? ss : 0.f;
    }
}

__device__ __forceinline__ unsigned dpp_qx1(unsigned v) { return (unsigned)__builtin_amdgcn_update_dpp(0, (int)v, 0xB1, 0xF, 0xF, true); }
__device__ __forceinline__ unsigned dpp_qx2(unsigned v) { return (unsigned)__builtin_amdgcn_update_dpp(0, (int)v, 0x4E, 0xF, 0xF, true); }
__device__ __forceinline__ void quad_transpose(unsigned (&v)[4], int t) {
    {
        const unsigned s0 = (t & 1) ? v[0] : v[1], r0 = dpp_qx1(s0);
        const unsigned s1 = (t & 1) ? v[2] : v[3], r1 = dpp_qx1(s1);
        if (t & 1) { v[0] = r0; v[2] = r1; } else { v[1] = r0; v[3] = r1; }
    }
    {
        const unsigned s0 = (t & 2) ? v[0] : v[2], r0 = dpp_qx2(s0);
        const unsigned s1 = (t & 2) ? v[1] : v[3], r1 = dpp_qx2(s1);
        if (t & 2) { v[0] = r0; v[1] = r1; } else { v[2] = r0; v[3] = r1; }
    }
}
__device__ __forceinline__ unsigned hbits(float x) { const hf h = (hf)x; return (unsigned)__builtin_bit_cast(unsigned short, h); }
__device__ __forceinline__ void store_tr4(unsigned short* base  , int rowoff, int l15, unsigned (&u)[4]) {
    const int t = l15 & 3;
    quad_transpose(u, t);
    uint2 pk; pk.x = u[0] | (u[1] << 16); pk.y = u[2] | (u[3] << 16);
    *(uint2*)(base + (size_t)(rowoff + t) * LP - t) = pk;
}

#define COLO(j) ((((j) >> 1) * 32) + lg * 8 + (((j) & 1) * 4))
enum { EPI_SWIGLU = 0, EPI_RESID = 1, EPI_FINAL = 2, EPI_EVEN = 3, EPI_ODD = 4 };

template <int BM>
__device__ __forceinline__ bool gemm_item(const Ctx& c, int it, int NT, int& mt, int& nt) {
    const int x = c.xcd, slot = c.slot, nslots = c.nslots;
    const int MTT = TP / BM;
    const int base = MTT / 8, rem = MTT % 8;
    const int mb = base + (x < rem ? 1 : 0);
    const int mstart = x * base + (x < rem ? x : rem);
    const int li = it * nslots + slot;
    if (li >= mb * NT) return false;
    const int per_g = 8 * NT;
    const int g = li / per_g, r = li - g * per_g;
    int gsz = mb - g * 8; gsz = gsz > 8 ? 8 : gsz;
    nt = r / gsz;
    mt = mstart + g * 8 + (r - nt * gsz);
    return true;
}

template <int EPI, int MI>
__device__ __forceinline__ void gemm_epilogue(f4 (&acc)[MI][4], float rsl, int m0, int n0, int nt, const Ctx& c, float ep_scale, const float* ep_g1, const float* ep_g2, int wm, int wn, int l15, int lg) {
    if constexpr (EPI == EPI_SWIGLU) {
        hf* act = c.big;
#pragma unroll
        for (int i = 0; i < MI; ++i) {
            const int m = m0 + wm * (MI * 16) + i * 16 + l15;
            const float rs = __shfl(rsl, i * 16 + l15);
            h8 o;
#pragma unroll
            for (int jp = 0; jp < 2; ++jp)
#pragma unroll
                for (int r = 0; r < 4; ++r) {
                    const float g = acc[i][2 * jp][r] * rs, u = acc[i][2 * jp + 1][r] * rs;
                    o[jp * 4 + r] = (hf)(silu_f(g) * u);
                }
            *(h8*)(act + (size_t)m * DFF + (n0 >> 1) + wn * 32 + lg * 8) = o;
        }
    } else if constexpr (EPI == EPI_RESID || EPI == EPI_FINAL) {
#pragma unroll
        for (int i = 0; i < MI; ++i) {
            const int m = m0 + wm * (MI * 16) + i * 16 + l15;
            const int b = m / LP, pp = m - b * LP;
            const bool pad = pp < 48;
            float ss = 0.f;
#pragma unroll
            for (int jp = 0; jp < 2; ++jp) {
                const int col = n0 + wn * 64 + jp * 32 + lg * 8;
                hf* hp = c.h16 + (size_t)m * 1024 + col;
                const h8 old = *(const h8*)hp;
                f4 v0, v1;
#pragma unroll
                for (int r = 0; r < 4; ++r) {
                    v0[r] = (float)old[r] + (pad ? 0.f : ep_scale * acc[i][2 * jp][r]);
                    v1[r] = (float)old[4 + r] + (pad ? 0.f : ep_scale * acc[i][2 * jp + 1][r]);
                }
                if constexpr (EPI == EPI_FINAL) {
                    if (pp >= 64) {
                        float* op = c.out + ((size_t)b * 2048 + (pp - 64)) * 1024 + col;
                        *(f4*)op = v0; *(f4*)(op + 4) = v1;
                    }
                } else {
                    h8 nw;
#pragma unroll
                    for (int r = 0; r < 4; ++r) {
                        nw[r] = (hf)v0[r]; nw[4 + r] = (hf)v1[r];
                        const float q0 = (float)nw[r], q1 = (float)nw[4 + r];
                        ss += q0 * q0 + q1 * q1;
                    }
                    *(h8*)hp = nw;
                }
                __builtin_amdgcn_sched_barrier(0);
            }
            if constexpr (EPI == EPI_RESID) {
                ss += __shfl_xor(ss, 16); ss += __shfl_xor(ss, 32);
                if (lg == 0) c.part[(size_t)m * 16 + nt * 2 + wn] = ss;
            }
        }
    } else if constexpr (EPI == EPI_EVEN) {
        hf* P = c.big;
        const int g = (n0 >> 6) + wn;
        if (g >= 82) return;
        int type, hidx = 0, coff = 0;
        if (g < 8) { type = 0; hidx = g; coff = P_AQ + g * 64; }
        else if (g < 16) { type = 1; hidx = g - 8; coff = P_AK + (g - 8) * 64; }
        else if (g < 24) { type = 2; hidx = g - 16; }
        else if (g < 32) { type = 3; coff = P_IQ + (g - 24) * 64; }
        else if (g == 32) { type = 3; coff = P_IK; }
        else if (g == 33) { type = 3; coff = P_IW; }
        else if (g < 42) { type = 4; hidx = g - 34; coff = P_BQ + (g - 34) * 64; }
        else if (g < 50) { type = 5; hidx = g - 42; coff = P_BK + (g - 42) * 64; }
        else if (g < 66) { type = 6; hidx = g - 50; }
        else { type = 7; coff = P_SBG + (g - 66) * 64; }
        float l2g = 0.f;
        if (type == 5) l2g = __log2f(1.0f - exp2f(-5.0f - (float)hidx));
#pragma unroll
        for (int i = 0; i < MI; ++i) {
            const int m = m0 + wm * (MI * 16) + i * 16 + l15;
            const int b = m / LP, pp = m - b * LP;
            const float rs = __shfl(rsl, i * 16 + l15);
            f4 v[4];
#pragma unroll
            for (int j = 0; j < 4; ++j) v[j] = acc[i][j] * rs;
            if (type == 0 || type == 1) {
                float ss = 0.f;
#pragma unroll
                for (int j = 0; j < 4; ++j)
#pragma unroll
                    for (int r = 0; r < 4; ++r) ss += v[j][r] * v[j][r];
                ss += __shfl_xor(ss, 16); ss += __shfl_xor(ss, 32);
                const float hr = rsqrtf(ss * (1.0f / 64.0f) + 1e-6f) * (type == 0 ? 0.125f : 1.0f);
                const float* gn = (type == 0) ? ep_g1 : ep_g2;
#pragma unroll
                for (int j = 0; j < 4; ++j) {
                    const f4 gv = *(const f4*)(gn + COLO(j));
                    v[j] = v[j] * hr * gv;
                }
            } else if (type == 4 || type == 5) {
                const float pos = (float)(pp - 48);
#pragma unroll
                for (int j = 0; j < 2; ++j)
#pragma unroll
                    for (int r = 0; r < 4; ++r) {
                        const float ang = pos * ROT_INV[COLO(j) + r];
                        const float rv = ang * 0.15915494f;
                        const float er = fmaf(ang, 0.15915494f, -rv) + ang * 1.4069382e-9f;
                        const float fr = (rv - floorf(rv)) + er;
                        const float sn = __builtin_amdgcn_sinf(fr), cs = __builtin_amdgcn_cosf(fr);
                        const float x1 = v[j][r], x2 = v[j + 2][r];
                        v[j][r] = x1 * cs - x2 * sn;
                        v[j + 2][r] = x1 * sn + x2 * cs;
                    }
                if (type == 5) {
#pragma unroll
                    for (int j = 0; j < 4; ++j) v[j] = v[j] * 0.125f;
                    const float dec = exp2f((float)(63 - (pp & 63)) * l2g);
                    unsigned short* kd = (unsigned short*)(c.bkdT + ((size_t)(b * 8 + hidx) * 64) * LP + pp);
#pragma unroll
                    for (int j = 0; j < 4; ++j) {
                        unsigned u[4];
#pragma unroll
                        for (int r = 0; r < 4; ++r) u[r] = hbits(v[j][r] * dec);
                        store_tr4(kd, COLO(j), l15, u);
                    }
                }
            } else if (type == 7) {
#pragma unroll
                for (int j = 0; j < 4; ++j)
#pragma unroll
                    for (int r = 0; r < 4; ++r) v[j][r] = silu_f(v[j][r]);
            }
            if (type == 2) {
                unsigned short* d = (unsigned short*)(c.avT + ((size_t)(b * 8 + hidx) * 64) * LP + pp);
#pragma unroll
                for (int j = 0; j < 4; ++j) {
                    unsigned u[4];
#pragma unroll
                    for (int r = 0; r < 4; ++r) u[r] = f2bf(v[j][r]);
                    store_tr4(d, COLO(j), l15, u);
                }
            } else if (type == 6) {
                unsigned short* d = (unsigned short*)(c.bvT + ((size_t)(b * 8 + (hidx >> 1)) * 128 + (hidx & 1) * 64) * LP + pp);
#pragma unroll
                for (int j = 0; j < 4; ++j) {
                    unsigned u[4];
#pragma unroll
                    for (int r = 0; r < 4; ++r) u[r] = hbits(v[j][r]);
                    store_tr4(d, COLO(j), l15, u);
                }
            } else {
#pragma unroll
                for (int jp = 0; jp < 2; ++jp) {
                    h8 o;
#pragma unroll
                    for (int r = 0; r < 4; ++r) { o[r] = (hf)v[2 * jp][r]; o[4 + r] = (hf)v[2 * jp + 1][r]; }
                    *(h8*)(P + (size_t)m * PLD + coff + jp * 32 + lg * 8) = o;
                }
            }
        }
    } else {
        hf* P2 = c.big;
        const int g = (n0 >> 6) + wn;
        int type, hidx = 0, coff = 0;
        if (g < 8) { type = 0; coff = P2_CQ + g * 64; }
        else if (g < 10) { type = 1; coff = P2_CK + (g - 8) * 64; }
        else if (g < 12) { type = 2; hidx = g - 10; }
        else { type = 3; coff = P2_DX + (g - 12) * 64; }
#pragma unroll
        for (int i = 0; i < MI; ++i) {
            const int m = m0 + wm * (MI * 16) + i * 16 + l15;
            const int b = m / LP, pp = m - b * LP;
            const float rs = __shfl(rsl, i * 16 + l15);
            f4 v[4];
#pragma unroll
            for (int j = 0; j < 4; ++j) v[j] = acc[i][j] * rs;
            if (type == 0 || type == 1) {
                float ss = 0.f;
#pragma unroll
                for (int j = 0; j < 4; ++j)
#pragma unroll
                    for (int r = 0; r < 4; ++r) ss += v[j][r] * v[j][r];
                ss += __shfl_xor(ss, 16); ss += __shfl_xor(ss, 32);
                const float hr = rsqrtf(ss * (1.0f / 64.0f) + 1e-6f) * (type == 0 ? 0.125f : 1.0f);
                const float* gn = (type == 0) ? ep_g1 : ep_g2;
#pragma unroll
                for (int j = 0; j < 4; ++j) {
                    const f4 gv = *(const f4*)(gn + COLO(j));
                    v[j] = v[j] * hr * gv;
                }
            }
            if (type == 2) {
                unsigned short* d = (unsigned short*)(c.cvT + ((size_t)(b * 2 + hidx) * 64) * LP + pp);
#pragma unroll
                for (int j = 0; j < 4; ++j) {
                    unsigned u[4];
#pragma unroll
                    for (int r = 0; r < 4; ++r) u[r] = f2bf(v[j][r]);
                    store_tr4(d, COLO(j), l15, u);
                }
            } else {
#pragma unroll
                for (int jp = 0; jp < 2; ++jp) {
                    h8 o;
#pragma unroll
                    for (int r = 0; r < 4; ++r) { o[r] = (hf)v[2 * jp][r]; o[4 + r] = (hf)v[2 * jp + 1][r]; }
                    *(h8*)(P2 + (size_t)m * P2LD + coff + jp * 32 + lg * 8) = o;
                }
            }
        }
    }
}

template <int EPI, int MI>
__device__ __forceinline__ void gemm_phase(const hf* __restrict__ A, int lda, const hf* __restrict__ Bt, int N, int K, const Ctx& c, float ep_scale, const float* ep_g1, const float* ep_g2, char* smem) {
    constexpr int BM = MI * 32;
    const int tid = tid_(), lane = tid & 63, w = tid >> 6, wm = w >> 1, wn = w & 1, l15 = lane & 15, lg = lane >> 4;
    hf* As = (hf*)smem;
    hf* Bs = As + 2 * 128 * 64;
    const int NT = N >> 7, nk = K >> 6;
    const int lrow = tid >> 3, lcol = (tid & 7) * 8;
    const int gcol = ((tid & 7) ^ ((lrow >> 1) & 7)) * 8;
    const int rc0 = (lg ^ (l15 >> 1)) * 8, rc1 = ((4 + lg) ^ (l15 >> 1)) * 8;
    int mt, nt;
    bool have = gemm_item<BM>(c, 0, NT, mt, nt);
    if (!have) return;
    const hf* Ap = A + (size_t)(mt * BM + lrow) * lda + gcol;
    const hf* Bp = Bt + (size_t)(nt * 128 + lrow) * K + gcol;
    hf* const adst = As + lrow * 64 + lcol;
    hf* const bdst = Bs + lrow * 64 + lcol;
#define GEMM_DMA(LA, LB, STAGE)                                                                                               \
    {                                                                                                                         \
        _Pragma("unroll") for (int i = 0; i < MI; ++i)                                                                        \
            __builtin_amdgcn_global_load_lds((const unsigned*)((LA) + (size_t)(32 * i) * lda),                                \
                                             (unsigned*)(adst + (STAGE) * (128 * 64) + (32 * i) * 64), 16, 0, 0);             \
        _Pragma("unroll") for (int i = 0; i < 4; ++i)                                                                         \
            __builtin_amdgcn_global_load_lds((const unsigned*)((LB) + (size_t)(32 * i) * K),                                  \
                                             (unsigned*)(bdst + (STAGE) * (128 * 64) + (32 * i) * 64), 16, 0, 0);             \
    }
    GEMM_DMA(Ap, Bp, 0)
    __syncthreads();
    for (int it = 0; have; ++it) {
        int mtn, ntn;
        const bool haven = gemm_item<BM>(c, it + 1, NT, mtn, ntn);
        const hf* Apn = haven ? A + (size_t)(mtn * BM + lrow) * lda + gcol : Ap;
        const hf* Bpn = haven ? Bt + (size_t)(ntn * 128 + lrow) * K + gcol : Bp;
        f4 acc[MI][4];
#pragma unroll
        for (int i = 0; i < MI; ++i)
#pragma unroll
            for (int j = 0; j < 4; ++j) acc[i][j] = (f4){0.f, 0.f, 0.f, 0.f};
        f4 pr0, pr1, pr2, pr3;
        float rsl = 0.f;
        constexpr bool NEED_RS = (EPI == EPI_SWIGLU || EPI == EPI_EVEN || EPI == EPI_ODD);
        if constexpr (NEED_RS) {
            const int rl = lane < MI * 16 ? lane : MI * 16 - 1;
            const f4* pp = (const f4*)(c.part + (size_t)(mt * BM + wm * (MI * 16) + rl) * 16);
            pr0 = pp[0]; pr1 = pp[1]; pr2 = pp[2]; pr3 = pp[3];
        }
        for (int ks = 0; ks < nk; ks += 2) {
            if constexpr (NEED_RS) {
                if (ks == 2) {
                    const float sm = (((pr0[0] + pr0[1]) + (pr0[2] + pr0[3])) + ((pr1[0] + pr1[1]) + (pr1[2] + pr1[3]))) +
                                     (((pr2[0] + pr2[1]) + (pr2[2] + pr2[3])) + ((pr3[0] + pr3[1]) + (pr3[2] + pr3[3])));
                    rsl = rsqrtf(sm * (1.0f / 1024.0f) + 1e-6f);
                }
            }
            const bool tail = (ks + 2 >= nk);
            const hf* la1 = Ap + (ks + 1) * 64;
            const hf* lb1 = Bp + (ks + 1) * 64;
            const hf* la2 = tail ? Apn : Ap + (ks + 2) * 64;
            const hf* lb2 = tail ? Bpn : Bp + (ks + 2) * 64;
#pragma unroll
            for (int half = 0; half < 2; ++half) {
                const hf* as = As + half * (128 * 64) + (wm * (MI * 16) + l15) * 64;
                const hf* bs = Bs + half * (128 * 64) + (wn * 64 + l15) * 64;
                h8 af[2][MI], bf[2][4];
#pragma unroll
                for (int kk = 0; kk < 2; ++kk) {
#pragma unroll
                    for (int i = 0; i < MI; ++i) af[kk][i] = *(const h8*)(as + i * 16 * 64 + (kk ? rc1 : rc0));
#pragma unroll
                    for (int i = 0; i < 4; ++i) bf[kk][i] = *(const h8*)(bs + i * 16 * 64 + (kk ? rc1 : rc0));
                }
                __builtin_amdgcn_sched_barrier(0);
                __builtin_amdgcn_s_setprio(1);
#pragma unroll
                for (int i = 0; i < MI; ++i)
#pragma unroll
                    for (int j = 0; j < 4; ++j) acc[i][j] = mfma16(bf[0][j], af[0][i], acc[i][j]);
                __builtin_amdgcn_s_setprio(0);
                __builtin_amdgcn_sched_barrier(0);
                if (half == 0) GEMM_DMA(la1, lb1, 1)
                else GEMM_DMA(la2, lb2, 0)
                __builtin_amdgcn_sched_barrier(0);
                __builtin_amdgcn_s_setprio(1);
#pragma unroll
                for (int i = 0; i < MI; ++i)
#pragma unroll
                    for (int j = 0; j < 4; ++j) acc[i][j] = mfma16(bf[1][j], af[1][i], acc[i][j]);
                __builtin_amdgcn_s_setprio(0);
                __syncthreads();
            }
        }
        gemm_epilogue<EPI, MI>(acc, rsl, mt * BM, nt * 128, nt, c, ep_scale, ep_g1, ep_g2, wm, wn, l15, lg);
        mt = mtn; nt = ntn; Ap = Apn; Bp = Bpn; have = haven;
    }
#undef GEMM_DMA
}

template <int EPI>
__device__ __forceinline__ void gemm_wide(const hf* __restrict__ A, int lda, const hf* __restrict__ Bt, int N, int K, const Ctx& c, float ep_scale, const float* ep_g1, const float* ep_g2, char* smem) {
    const int tid = tid_(), lane = tid & 63, w = tid >> 6, wm = w >> 1, wn = w & 1, l15 = lane & 15, lg = lane >> 4;
    const int NT = N >> 8, nk = K >> 5;
    const int rloc = lane >> 2;
    const int fsw_d = (0x1320 >> (((rloc >> 2) & 3) * 4)) & 3;
    const int gchunk = ((lane & 3) ^ fsw_d) * 8;
    const int fsw_r = (0x1320 >> (((l15 >> 2) & 3) * 4)) & 3;
    const int rpos = (lg ^ fsw_r) * 16;
    char* const ldsb = smem;
    const int dst0 = tid * 16;
    int mt, nt;
    bool have = gemm_item<128>(c, 0, NT, mt, nt);
    if (!have) return;
    const int aoff = (16 * w + rloc) * lda + gchunk, boff = (16 * w + rloc) * K + gchunk;
    const hf* Ap = A + (size_t)(mt * 128) * lda;
    const hf* Bp = Bt + (size_t)(nt * 256) * K;
#define WIDE_DMA(LA, LB, STAGE)                                                                                            \
    {                                                                                                                      \
        char* sb_ = ldsb + (STAGE) * 24576 + dst0;                                                                         \
        _Pragma("unroll") for (int i = 0; i < 2; ++i)                                                                      \
            __builtin_amdgcn_global_load_lds((const unsigned*)(((LA) + (size_t)(64 * i) * lda) + aoff), (unsigned*)(sb_ + i * 4096), 16, 0, 0);          \
        _Pragma("unroll") for (int i = 0; i < 4; ++i)                                                                      \
            __builtin_amdgcn_global_load_lds((const unsigned*)(((LB) + (size_t)(64 * i) * K) + boff), (unsigned*)(sb_ + 8192 + i * 4096), 16, 0, 0);      \
    }
    WIDE_DMA(Ap, Bp, 0)
    WIDE_DMA(Ap + 32, Bp + 32, 1)
    asm volatile("s_waitcnt vmcnt(6)" ::: "memory");
    __builtin_amdgcn_s_barrier();
    asm volatile("" ::: "memory");
    int st = 0;
    for (int it = 0; have; ++it) {
        int mtn, ntn;
        const bool haven = gemm_item<128>(c, it + 1, NT, mtn, ntn);
        const hf* Apn = haven ? A + (size_t)(mtn * 128) * lda : Ap;
        const hf* Bpn = haven ? Bt + (size_t)(ntn * 256) * K : Bp;
        f4 acc0[4][4], acc1[4][4];
#pragma unroll
        for (int i = 0; i < 4; ++i)
#pragma unroll
            for (int j = 0; j < 4; ++j) { acc0[i][j] = (f4){0.f, 0.f, 0.f, 0.f}; acc1[i][j] = (f4){0.f, 0.f, 0.f, 0.f}; }
        float rsl = 0.f;
        for (int ks = 0; ks < nk; ++ks) {
            if (ks == nk - 1) rsl = row_rs(c.part, mt * 128 + wm * 64 + lane);
            const bool tail = (ks + 2 >= nk);
            const hf* la = tail ? Apn + (ks + 2 - nk) * 32 : Ap + (ks + 2) * 32;
            const hf* lb = tail ? Bpn + (ks + 2 - nk) * 32 : Bp + (ks + 2) * 32;
            const int stn = st >= 1 ? st - 1 : 2;
            const char* sa = ldsb + st * 24576 + (wm * 64 + l15) * 64 + rpos;
            const char* sbp = ldsb + st * 24576 + 8192 + (wn * 128 + l15) * 64 + rpos;
            h8 af[4], bf[4];
#pragma unroll
            for (int i = 0; i < 4; ++i) af[i] = *(const h8*)(sa + i * 1024);
#pragma unroll
            for (int j = 0; j < 4; ++j) bf[j] = *(const h8*)(sbp + j * 1024);
            __builtin_amdgcn_sched_barrier(0);
            __builtin_amdgcn_s_setprio(1);
#pragma unroll
            for (int i = 0; i < 4; ++i)
#pragma unroll
                for (int j = 0; j < 4; ++j) acc0[i][j] = mfma16(bf[j], af[i], acc0[i][j]);
            __builtin_amdgcn_s_setprio(0);
            __builtin_amdgcn_sched_barrier(0);
#pragma unroll
            for (int j = 0; j < 4; ++j) bf[j] = *(const h8*)(sbp + (4 + j) * 1024);
            __builtin_amdgcn_sched_barrier(0);
            WIDE_DMA(la, lb, stn)
            __builtin_amdgcn_sched_barrier(0);
            __builtin_amdgcn_s_setprio(1);
#pragma unroll
            for (int i = 0; i < 4; ++i)
#pragma unroll
                for (int j = 0; j < 4; ++j) acc1[i][j] = mfma16(bf[j], af[i], acc1[i][j]);
            __builtin_amdgcn_s_setprio(0);
            __builtin_amdgcn_sched_barrier(0);
            asm volatile("s_waitcnt vmcnt(6)" ::: "memory");
            __builtin_amdgcn_s_barrier();
            asm volatile("" ::: "memory");
            st = st == 2 ? 0 : st + 1;
        }
        gemm_epilogue<EPI, 4>(acc0, rsl, mt * 128, nt * 256 + wn * 128, nt * 2 + wn, c, ep_scale, ep_g1, ep_g2, wm, 0, l15, lg);
        __builtin_amdgcn_sched_barrier(0);
        gemm_epilogue<EPI, 4>(acc1, rsl, mt * 128, nt * 256 + wn * 128, nt * 2 + wn, c, ep_scale, ep_g1, ep_g2, wm, 1, l15, lg);
        mt = mtn; nt = ntn; Ap = Apn; Bp = Bpn; have = haven;
    }
    asm volatile("s_waitcnt vmcnt(0)" ::: "memory");
    __syncthreads();
#undef WIDE_DMA
}

__device__ __forceinline__ unsigned cvt_pk_bf16(float lo, float hi) { unsigned r; asm("v_cvt_pk_bf16_f32 %0, %1, %2" : "=v"(r) : "v"(lo), "v"(hi)); return r; }
typedef unsigned u4 __attribute__((ext_vector_type(4)));

template <int MODE>
__device__ __forceinline__ void attn_wave(const hf* Q, int ldq, const hf* Kb, int ldk, const short* VT, int ntiles, int T_first,
                                          const uint64_t* mrow, float nbl2, float sink_p, hf* O, int ldo, int lane) {
    const int l15 = lane & 15, lg = lane >> 4;
    h8 qf[4][2];
#pragma unroll
    for (int qt = 0; qt < 4; ++qt)
#pragma unroll
        for (int kk = 0; kk < 2; ++kk) qf[qt][kk] = *(const h8*)(Q + (size_t)(qt * 16 + l15) * ldq + kk * 32 + lg * 8);
    f4 ot[4][4];
#pragma unroll
    for (int a = 0; a < 4; ++a)
#pragma unroll
        for (int b = 0; b < 4; ++b) ot[a][b] = (f4){0.f, 0.f, 0.f, 0.f};
    float lsum[4] = {0.f, 0.f, 0.f, 0.f};
    const hf* kbase = Kb + (size_t)((l15 >> 2) * 8 + (l15 & 3)) * ldk + lg * 8;
    const short* vbase = VT + (size_t)((l15 >> 2) * 8 + (l15 & 3)) * LP + lg * 8;
    h8 kfA[2][2], kfB[2][2];
    s8 vfA[4], vfB[4];
    uint64_t mw[4];
#define ATT_TILE(it_) ((MODE == 1) ? ((it_) == 0 ? 0 : T_first + (it_) - 1) : (it_))
#define ATT_LOAD_HALF(KF, VF, T_, HH)                                                                        \
    {                                                                                                        \
        _Pragma("unroll") for (int s2 = 0; s2 < 2; ++s2)                                                     \
            _Pragma("unroll") for (int kk = 0; kk < 2; ++kk)                                                 \
                KF[s2][kk] = *(const h8*)(kbase + (size_t)((T_) * 64 + (HH) * 32 + 4 * s2) * ldk + kk * 32);   \
        _Pragma("unroll") for (int dt = 0; dt < 4; ++dt) {                                                   \
            VF[dt] = *(const s8*)(vbase + (size_t)((dt >> 1) * 32 + (dt & 1) * 4) * LP + (T_) * 64 + (HH) * 32); \
        }                                                                                                    \
    }
#define ATT_LOAD_MASK(MW, T_)                                                                                \
    {                                                                                                        \
        _Pragma("unroll") for (int qt = 0; qt < 4; ++qt) {                                                   \
            if (MODE == 0) MW[qt] = mrow[(size_t)(T_) * LP + qt * 16 + l15];                                 \
            else MW[qt] = ((T_) == 0) ? 0xFFFF000000000000ull : ~0ull;                                       \
        }                                                                                                    \
    }
#define ATT_COMPUTE(KF, VF, HH)                                                                              \
    {                                                                                                        \
        s8 pf[4];                                                                                            \
        _Pragma("unroll") for (int qt = 0; qt < 4; ++qt) {                                                   \
            f4 st0 = {0.f, 0.f, 0.f, 0.f}, st1 = {0.f, 0.f, 0.f, 0.f};                                       \
            st0 = mfma16(KF[0][0], qf[qt][0], st0); st0 = mfma16(KF[0][1], qf[qt][1], st0);                  \
            st1 = mfma16(KF[1][0], qf[qt][0], st1); st1 = mfma16(KF[1][1], qf[qt][1], st1);                  \
            const unsigned bits = (unsigned)(mw[qt] >> ((HH) * 32 + lg * 8));                                \
            float p0[4], p1[4];                                                                              \
            _Pragma("unroll") for (int r = 0; r < 4; ++r) {                                                  \
                p0[r] = __builtin_amdgcn_exp2f(st0[r] * LOG2E + nbl2); p0[r] = ((bits >> r) & 1u) ? p0[r] : 0.f;        \
                p1[r] = __builtin_amdgcn_exp2f(st1[r] * LOG2E + nbl2); p1[r] = ((bits >> (4 + r)) & 1u) ? p1[r] : 0.f;  \
                lsum[qt] += p0[r] + p1[r];                                                                   \
            }                                                                                                \
            u4 pk;                                                                                           \
            pk[0] = cvt_pk_bf16(p0[0], p0[1]); pk[1] = cvt_pk_bf16(p0[2], p0[3]);                            \
            pk[2] = cvt_pk_bf16(p1[0], p1[1]); pk[3] = cvt_pk_bf16(p1[2], p1[3]);                            \
            pf[qt] = __builtin_bit_cast(s8, pk);                                                             \
        }                                                                                                    \
        _Pragma("unroll") for (int dt = 0; dt < 4; ++dt)                                                     \
            _Pragma("unroll") for (int qt = 0; qt < 4; ++qt) ot[dt][qt] = mfma16b(VF[dt], pf[qt], ot[dt][qt]); \
    }
    {
        const int T0 = ATT_TILE(0);
        ATT_LOAD_MASK(mw, T0)
        ATT_LOAD_HALF(kfA, vfA, T0, 0)
    }
    for (int it = 0; it < ntiles; ++it) {
        const int T = ATT_TILE(it);
        const int itn = it + 1 < ntiles ? it + 1 : it;
        const int Tn = ATT_TILE(itn);
        ATT_LOAD_HALF(kfB, vfB, T, 1)
        __builtin_amdgcn_sched_barrier(0);
        ATT_COMPUTE(kfA, vfA, 0)
        __builtin_amdgcn_sched_barrier(0);
        ATT_LOAD_HALF(kfA, vfA, Tn, 0)
        __builtin_amdgcn_sched_barrier(0);
        ATT_COMPUTE(kfB, vfB, 1)
        __builtin_amdgcn_sched_barrier(0);
        ATT_LOAD_MASK(mw, Tn)
    }
#undef ATT_TILE
#undef ATT_LOAD_HALF
#undef ATT_LOAD_MASK
#undef ATT_COMPUTE
#pragma unroll
    for (int qt = 0; qt < 4; ++qt) {
        float l = lsum[qt];
        l += __shfl_xor(l, 16); l += __shfl_xor(l, 32);
        l += sink_p;
        const float inv = l > 0.f ? 1.0f / l : 0.f;
#pragma unroll
        for (int dp = 0; dp < 2; ++dp) {
            h8 o;
#pragma unroll
            for (int r = 0; r < 4; ++r) { o[r] = (hf)(ot[2 * dp][qt][r] * inv); o[4 + r] = (hf)(ot[2 * dp + 1][qt][r] * inv); }
            *(h8*)(O + (size_t)(qt * 16 + l15) * ldo + dp * 32 + lg * 8) = o;
        }
    }
}

__device__ __forceinline__ void e2_item(const Ctx& c, int b, int ch, int qg, char* smem) {
    const int tid = tid_(), lane = tid & 63, w = tid >> 6, l15 = lane & 15, lg = lane >> 4;
    const hf* P = c.big;
    const int qrow0 = b * LP + ch * 64 + qg * 16;
    if (ch <= 3) {
        if (w <= ch && lane < 16) c.mask[((size_t)b * 33 + w) * LP + (qrow0 - b * LP) + lane] = (w == 0) ? 0xFFFF000000000000ull : ~0ull;
        return;
    }
    hf* iqs = (hf*)smem;
    unsigned* cnts = (unsigned*)(smem + 16 * 520 * 2);
#pragma unroll
    for (int i = 0; i < 4; ++i) {
        const int q = tid + 256 * i, row = q >> 6, cc = (q & 63) * 8;
        *(h8*)(iqs + row * 520 + cc) = *(const h8*)(P + (size_t)(qrow0 + row) * PLD + P_IQ + cc);
    }
    float iwf[8];
    {
        const h8 iwv = *(const h8*)(P + (size_t)(qrow0 + l15) * PLD + P_IW);
#pragma unroll
        for (int h = 0; h < 8; ++h) iwf[h] = (float)iwv[h];
    }
    __syncthreads();
    unsigned uk[8][4][4];
    unsigned uk0[4];
    h8 kn0, kn1;
    const hf* kpn;
    {
        const hf* kp = P + (size_t)(b * LP + 48 + l15) * PLD + P_IK + lg * 8;
        kn0 = *(const h8*)kp; kn1 = *(const h8*)(kp + 32);
    }
#define E2_SCORE(KF0, KF1, SC)                                                          \
    {                                                                                   \
        const hf* iqp_ = iqs + l15 * 520 + lg * 8;                                      \
        asm volatile("" : "+v"(iqp_));     \
        _Pragma("unroll") for (int h = 0; h < 8; ++h) {                                 \
            const h8 q0 = *(const h8*)(iqp_ + h * 64);                                  \
            const h8 q1 = *(const h8*)(iqp_ + h * 64 + 32);                             \
            f4 d = {0.f, 0.f, 0.f, 0.f};                                                \
            d = mfma16(KF0, q0, d);                                                     \
            d = mfma16(KF1, q1, d);                                                     \
            _Pragma("unroll") for (int r = 0; r < 4; ++r) SC[r] += iwf[h] * fmaxf(d[r], 0.f); \
            if (h == 3) __builtin_amdgcn_sched_barrier(0);                              \
        }                                                                               \
    }
#define E2_KEY(X) ({ unsigned u_ = __float_as_uint(X); if (u_ == 0x80000000u) u_ = 0u; (u_ & 0x80000000u) ? ~u_ : (u_ | 0x80000000u); })
    {
        const h8 kf0 = kn0, kf1 = kn1;
        kpn = P + (size_t)(b * LP + (1 + w) * 64 + l15) * PLD + P_IK + lg * 8;
        asm volatile("" : "+v"(kpn));
        kn0 = *(const h8*)kpn; kn1 = *(const h8*)(kpn + 32);
        f4 sc = {0.f, 0.f, 0.f, 0.f};
        E2_SCORE(kf0, kf1, sc)
#pragma unroll
        for (int r = 0; r < 4; ++r) { unsigned u = (w == 0) ? E2_KEY(sc[r]) : 0u; asm volatile("" : "+v"(u)); uk0[r] = u; }
        __builtin_amdgcn_sched_barrier(0);
    }
#pragma unroll
    for (int jj = 0; jj < 8; ++jj) {
        const int j = 1 + w + 4 * jj;
        if (j <= ch) {
#pragma unroll
            for (int sub = 0; sub < 4; ++sub) {
                const h8 kf0 = kn0, kf1 = kn1;
                {
                    const int jn = (sub == 3) ? j + 4 : j;
                    kpn += (sub == 3) ? (size_t)208 * PLD : (size_t)16 * PLD;
                    asm volatile("" : "+v"(kpn));
                    if (jn <= ch && (sub < 3 || jj < 7)) { kn0 = *(const h8*)kpn; kn1 = *(const h8*)(kpn + 32); }
                }
                f4 sc = {0.f, 0.f, 0.f, 0.f};
                E2_SCORE(kf0, kf1, sc)
#pragma unroll
                for (int r = 0; r < 4; ++r) { unsigned u = E2_KEY(sc[r]); asm volatile("" : "+v"(u)); uk[jj][sub][r] = u; }
                __builtin_amdgcn_sched_barrier(0);
            }
        } else {
#pragma unroll
            for (int sub = 0; sub < 4; ++sub)
#pragma unroll
                for (int r = 0; r < 4; ++r) uk[jj][sub][r] = 0u;
        }
    }
    unsigned prefix = 0u;
    bool done = false;
    for (int bit = 31; bit >= 0; --bit) {
        const unsigned cand = prefix | (1u << bit);
        int cnt = 0;
#pragma unroll
        for (int r = 0; r < 4; ++r) cnt += (uk0[r] >= cand) ? 1 : 0;
#pragma unroll
        for (int jj = 0; jj < 8; ++jj) {
            if (1 + w + 4 * jj <= ch) {
#pragma unroll
                for (int sub = 0; sub < 4; ++sub)
#pragma unroll
                    for (int r = 0; r < 4; ++r) cnt += (uk[jj][sub][r] >= cand) ? 1 : 0;
            }
        }
        cnt += __shfl_xor(cnt, 16); cnt += __shfl_xor(cnt, 32);
        const int pb = (bit & 1) * 64;
        if (lane < 16) cnts[pb + w * 16 + lane] = (unsigned)cnt;
        __syncthreads();
        const int tot = (int)(cnts[pb + l15] + cnts[pb + 16 + l15] + cnts[pb + 32 + l15] + cnts[pb + 48 + l15]);
        if (!done) {
            if (tot >= 256) prefix = cand;
            if (tot == 256) done = true;
        }
        if (__all(done ? 1 : 0)) break;
    }
#define E2_TOTAL(CNT, PAR)                                                                                   \
    ({                                                                                                       \
        int c_ = (CNT);                                                                                      \
        c_ += __shfl_xor(c_, 16); c_ += __shfl_xor(c_, 32);                                                  \
        const int pb_ = (PAR) * 64;                                                                          \
        if (lane < 16) cnts[pb_ + w * 16 + lane] = (unsigned)c_;                                             \
        __syncthreads();                                                                                     \
        (int)(cnts[pb_ + l15] + cnts[pb_ + 16 + l15] + cnts[pb_ + 32 + l15] + cnts[pb_ + 48 + l15]);         \
    })
    __syncthreads();
    int X = 2112;
    if (!__all(done ? 1 : 0)) {
        int cge = 0, cgt = 0;
#pragma unroll
        for (int r = 0; r < 4; ++r) { cge += (uk0[r] >= prefix) ? 1 : 0; cgt += (uk0[r] > prefix) ? 1 : 0; }
#pragma unroll
        for (int jj = 0; jj < 8; ++jj) {
            if (1 + w + 4 * jj <= ch) {
#pragma unroll
                for (int sub = 0; sub < 4; ++sub)
#pragma unroll
                    for (int r = 0; r < 4; ++r) { cge += (uk[jj][sub][r] >= prefix) ? 1 : 0; cgt += (uk[jj][sub][r] > prefix) ? 1 : 0; }
            }
        }
        const int tot = E2_TOTAL(cge | (cgt << 16), 0);
        const int tge = tot & 0xFFFF, tgt = tot >> 16;
        const int need = 256 - tgt;
        const bool tie = (tge - tgt) > need;
        if (__any(tie ? 1 : 0)) {
            int lo = 0, hi = 2112;
            for (int itb = 0; itb < 12; ++itb) {
                const int mid = (lo + hi) >> 1;
                const int tm = mid - lg * 4;
                const int tmw = tm - w * 64;
                int cq = 0;
#pragma unroll
                for (int r = 0; r < 4; ++r) cq += (uk0[r] == prefix && (48 + r) < tm) ? 1 : 0;
#pragma unroll
                for (int jj = 0; jj < 8; ++jj) {
                    if (1 + w + 4 * jj <= ch) {
#pragma unroll
                        for (int sub = 0; sub < 4; ++sub)
#pragma unroll
                            for (int r = 0; r < 4; ++r)
                                cq += (uk[jj][sub][r] == prefix && ((1 + 4 * jj) * 64 + sub * 16 + r) < tmw) ? 1 : 0;
                    }
                }
                const int t2 = E2_TOTAL(cq, (itb + 1) & 1);
                if (t2 >= need) hi = mid; else lo = mid + 1;
            }
            if (tie) X = hi;
        }
    }
    const int XL = X - lg * 4, XLW = XL - w * 64;
#define E2_SEL(U, IDXC, XB) (((U) > prefix) || ((U) == prefix && (IDXC) < (XB)))
    if (w == 0) {
        unsigned m4 = 0u;
#pragma unroll
        for (int r = 0; r < 4; ++r) m4 |= E2_SEL(uk0[r], 48 + r, XL) ? (1u << r) : 0u;
        unsigned hi = m4 << (16 + lg * 4);
        hi |= __shfl_xor(hi, 16); hi |= __shfl_xor(hi, 32);
        if (lg == 0) c.mask[((size_t)b * 33 + 0) * LP + (qrow0 - b * LP) + l15] = ((uint64_t)hi << 32);
    }
#pragma unroll
    for (int jj = 0; jj < 8; ++jj) {
        const int j = 1 + w + 4 * jj;
        if (j <= ch) {
            unsigned lo = 0u, hi = 0u;
#pragma unroll
            for (int sub = 0; sub < 4; ++sub) {
                unsigned m4 = 0u;
#pragma unroll
                for (int r = 0; r < 4; ++r) m4 |= E2_SEL(uk[jj][sub][r], (1 + 4 * jj) * 64 + sub * 16 + r, XLW) ? (1u << r) : 0u;
                m4 <<= (lg * 4);
                if (sub == 0) lo |= m4; else if (sub == 1) lo |= m4 << 16; else if (sub == 2) hi |= m4; else hi |= m4 << 16;
            }
            lo |= __shfl_xor(lo, 16); lo |= __shfl_xor(lo, 32);
            hi |= __shfl_xor(hi, 16); hi |= __shfl_xor(hi, 32);
            if (lg == 0) c.mask[((size_t)b * 33 + j) * LP + (qrow0 - b * LP) + l15] = ((uint64_t)hi << 32) | (uint64_t)lo;
        }
    }
#undef E2_TOTAL
#undef E2_SEL
#undef E2_SCORE
#undef E2_KEY
}

__device__ __forceinline__ void retention_item(const Ctx& c, int b, int h, char* smem) {
    const int tid = tid_(), lane = tid & 63, w = tid >> 6, l15 = lane & 15, lg = lane >> 4;
    hf* P = c.big;
    const float l2g = __log2f(1.0f - exp2f(-5.0f - (float)h));
    const int prow = (l15 >> 2) * 8 + (l15 & 3);
    const hf* Pb = P + (size_t)b * LP * PLD;
    const hf* KDT = c.bkdT + ((size_t)(b * 8 + h) * 64) * LP;
    const hf* VT = c.bvT + ((size_t)(b * 8 + h) * 128 + w * 32) * LP;
    float* parts = (float*)smem;
    f4 S[4][2];
#pragma unroll
    for (int td = 0; td < 4; ++td)
#pragma unroll
        for (int te = 0; te < 2; ++te) S[td][te] = (f4){0.f, 0.f, 0.f, 0.f};
    const float cdec = exp2f(64.0f * l2g);
    float qdec[4];
#pragma unroll
    for (int ti = 0; ti < 4; ++ti) qdec[ti] = exp2f((float)(ti * 16 + l15 + 1) * l2g);
    for (int n = 0; n < 33; ++n) {
        const int row0 = n * 64;
        h8 qf[4][2];
#pragma unroll
        for (int ti = 0; ti < 4; ++ti)
#pragma unroll
            for (int kk = 0; kk < 2; ++kk) {
                qf[ti][kk] = *(const h8*)(Pb + (size_t)(row0 + ti * 16 + l15) * PLD + P_BQ + h * 64 + kk * 32 + lg * 8);
            }
        f4 out[2][4];
#pragma unroll
        for (int te = 0; te < 2; ++te)
#pragma unroll
            for (int ti = 0; ti < 4; ++ti) out[te][ti] = (f4){0.f, 0.f, 0.f, 0.f};
        if (n > 0) {
            h8 sf[2][2];
#pragma unroll
            for (int tdp = 0; tdp < 2; ++tdp)
#pragma unroll
                for (int te = 0; te < 2; ++te) {
                    h8 t;
#pragma unroll
                    for (int r = 0; r < 4; ++r) { t[r] = (hf)S[2 * tdp][te][r]; t[4 + r] = (hf)S[2 * tdp + 1][te][r]; }
                    sf[tdp][te] = t;
                }
#pragma unroll
            for (int te = 0; te < 2; ++te)
#pragma unroll
                for (int ti = 0; ti < 4; ++ti) {
                    f4 o = {0.f, 0.f, 0.f, 0.f};
                    o = mfma16(sf[0][te], qf[ti][0], o);
                    o = mfma16(sf[1][te], qf[ti][1], o);
                    out[te][ti] = o * qdec[ti];
                }
        }
        h8 vfs[2][2];
#pragma unroll
        for (int tjp = 0; tjp < 2; ++tjp) {
            h8 kf[2][2];
#pragma unroll
            for (int s2 = 0; s2 < 2; ++s2)
#pragma unroll
                for (int kk = 0; kk < 2; ++kk) {
                    kf[s2][kk] = *(const h8*)(Pb + (size_t)(row0 + tjp * 32 + prow + 4 * s2) * PLD + P_BK + h * 64 + kk * 32 + lg * 8);
                }
#pragma unroll
            for (int te = 0; te < 2; ++te) {
                vfs[tjp][te] = *(const h8*)(VT + (size_t)(prow + 4 * te) * LP + row0 + tjp * 32 + lg * 8);
            }
            h8 pf[4];
#pragma unroll
            for (int ti = 0; ti < 4; ++ti) {
                f4 a0 = {0.f, 0.f, 0.f, 0.f}, a1 = {0.f, 0.f, 0.f, 0.f};
                a0 = mfma16(kf[0][0], qf[ti][0], a0); a0 = mfma16(kf[0][1], qf[ti][1], a0);
                a1 = mfma16(kf[1][0], qf[ti][0], a1); a1 = mfma16(kf[1][1], qf[ti][1], a1);
                const int i = ti * 16 + l15;
                h8 t;
#pragma unroll
                for (int r = 0; r < 4; ++r) {
                    const int j0 = tjp * 32 + lg * 8 + r, j1 = j0 + 4;
                    const float d0 = (i >= j0) ? exp2f((float)(i - j0) * l2g) : 0.f;
                    const float d1 = (i >= j1) ? exp2f((float)(i - j1) * l2g) : 0.f;
                    t[r] = (hf)(a0[r] * d0); t[4 + r] = (hf)(a1[r] * d1);
                }
                pf[ti] = t;
            }
#pragma unroll
            for (int te = 0; te < 2; ++te)
#pragma unroll
                for (int ti = 0; ti < 4; ++ti) out[te][ti] = mfma16(vfs[tjp][te], pf[ti], out[te][ti]);
        }
        if (n < 32)
#pragma unroll
        for (int td = 0; td < 4; ++td) {
            h8 kd[2];
#pragma unroll
            for (int tjp = 0; tjp < 2; ++tjp) {
                kd[tjp] = *(const h8*)(KDT + (size_t)((td >> 1) * 32 + prow + 4 * (td & 1)) * LP + row0 + tjp * 32 + lg * 8);
            }
#pragma unroll
            for (int te = 0; te < 2; ++te) {
                f4 s = S[td][te] * cdec;
                s = mfma16(kd[0], vfs[0][te], s);
                s = mfma16(kd[1], vfs[1][te], s);
                S[td][te] = s;
            }
        }
        float ss[4];
#pragma unroll
        for (int ti = 0; ti < 4; ++ti) {
            float a = 0.f;
#pragma unroll
            for (int te = 0; te < 2; ++te)
#pragma unroll
                for (int r = 0; r < 4; ++r) a += out[te][ti][r] * out[te][ti][r];
            a += __shfl_xor(a, 16); a += __shfl_xor(a, 32);
            ss[ti] = a;
        }
        const int pb = (n & 1) * 256;
        if (lg == 0) {
#pragma unroll
            for (int ti = 0; ti < 4; ++ti) parts[pb + w * 64 + ti * 16 + l15] = ss[ti];
        }
        __syncthreads();
#pragma unroll
        for (int ti = 0; ti < 4; ++ti) {
            const int ii = ti * 16 + l15;
            const float tot = (parts[pb + ii] + parts[pb + 64 + ii]) + (parts[pb + 128 + ii] + parts[pb + 192 + ii]);
            const float rsn = rsqrtf(tot * (1.0f / 128.0f) + 1e-6f);
            {
                hf* gp = P + (size_t)(b * LP + row0 + ii) * PLD + P_SBG + h * 128 + w * 32 + lg * 8;
                const h8 gv = *(const h8*)gp;
                h8 o;
#pragma unroll
                for (int r = 0; r < 4; ++r) { o[r] = (hf)(out[0][ti][r] * rsn * (float)gv[r]); o[4 + r] = (hf)(out[1][ti][r] * rsn * (float)gv[4 + r]); }
                *(h8*)gp = o;
            }
        }
    }
    __syncthreads();
}

__device__ __forceinline__ void pool_item(const Ctx& c, int it) {
    hf* P2 = c.big;
    const int tid = tid_();
#pragma unroll 1
    for (int k = 0; k < 8; ++k) {
        const int q = tid + 256 * k;
        const int row = it * 32 + (q >> 6), ch0 = (q & 63) * 8;
        const int pp = row % LP;
        h8 o;
        if (pp < 48) {
#pragma unroll
            for (int e = 0; e < 8; ++e) o[e] = (hf)0.f;
        } else {
            const int wnd = 2 << (ch0 >> 7);
            float a[8];
#pragma unroll
            for (int e = 0; e < 8; ++e) a[e] = 0.f;
            const hf* xp = P2 + (size_t)row * P2LD + P2_DX + ch0;
            const h8 x0 = *(const h8*)xp;
            for (int t = 0; t < wnd; ++t) {
                const h8 v = *(const h8*)(xp - (size_t)t * P2LD);
#pragma unroll
                for (int e = 0; e < 8; ++e) a[e] += (float)v[e];
            }
            int cnt = pp - 47; cnt = cnt < wnd ? cnt : wnd;
            const float ic = 1.0f / (float)cnt;
#pragma unroll
            for (int e = 0; e < 8; ++e) o[e] = (hf)(a[e] * ic - (float)x0[e]);
        }
        *(h8*)(P2 + (size_t)row * P2LD + P2_YD + ch0) = o;
    }
}

__global__ void __launch_bounds__(256, 2) fwd_megakernel(Params p) {
    __shared__ __attribute__((aligned(16))) char smem[SMEM_BYTES];
    __shared__ uint4 xb_words;
    if (threadIdx.x == 0) xb_words = make_uint4(0u, 0u, 0u, 0u);
    __syncthreads();
    XcdBarrier xb = xcd_barrier_post((unsigned*)(p.ws + WS_BAR), (volatile LAS unsigned*)&xb_words);
    {
        unsigned* sl = (unsigned*)(p.ws + WS_SLOT);
        if (threadIdx.x == 0) { volatile LAS unsigned* st = (volatile LAS unsigned*)&xb_words; st[2] = xb_add(&sl[xb.x * 64], 1u); }
    }
    Ctx c;
    c.W = (hf*)p.ws;
    c.h16 = (hf*)(p.ws + WS_H16);
    c.part = (float*)(p.ws + WS_PART);
    c.bkdT = (hf*)(p.ws + WS_BKDT);
    c.big = (hf*)(p.ws + WS_BIG);
    char* dob = (char*)p.out;
    c.avT = (short*)(dob + DO_AVT);
    c.bvT = (hf*)(dob + DO_BVT);
    c.mask = (uint64_t*)(dob + DO_MASK);
    c.cvT = (short*)(dob + DO_CVT);
    c.out = p.out;
    c.xcd = blockIdx.x & 7; c.slot = blockIdx.x >> 3; c.nslots = gridDim.x >> 3;
#pragma unroll 1
    for (int ph = 0; ph < 16; ++ph) {
        int kind;
        switch (ph) {
            case 0: kind = 0; break;
            case 1: case 7: case 9: case 14: kind = 1; break;
            case 2: case 6: case 8: case 10: case 13: kind = 2; break;
            case 3: kind = 3; break;
            case 4: kind = 4; break;
            case 5: kind = 5; break;
            case 11: kind = 6; break;
            case 12: kind = 7; break;
            default: kind = 8; break;
        }
        if (kind == 0) {
            prologue(p, c, smem);
        } else if (kind == 1) {
            const int wi = (ph == 1) ? 0 : (ph == 7) ? 1 : (ph == 9) ? 2 : 3;
            gemm_wide<EPI_SWIGLU>(c.h16, 1024, c.W + OFF_WFI(wi), 5632, 1024, c, 0.f, nullptr, nullptr, smem);
        } else if (kind == 2) {
            const hf* Bt; int lda, K; float scale;
            if (ph == 6) { Bt = c.W + OFF_WEO; lda = PLD; K = 1536; scale = 1.0f; }
            else if (ph == 13) { Bt = c.W + OFF_WOO; lda = P2LD; K = 1024; scale = 1.0f; }
            else { const int wi = (ph == 2) ? 0 : (ph == 8) ? 1 : 2; Bt = c.W + OFF_WFO(wi); lda = DFF; K = DFF; scale = 0.5f; }
            gemm_phase<EPI_RESID, 3>(c.big, lda, Bt, 1024, K, c, scale, nullptr, nullptr, smem);
        } else if (kind == 3) {
            gemm_wide<EPI_EVEN>(c.h16, 1024, c.W + OFF_WEI, 5376, 1024, c, 0.f, p.ev_a_q_norm, p.ev_a_k_norm, smem);
        } else if (kind == 4) {
            if (bid_() < 64) {
                xcd_barrier_arrive(xb);
                retention_item(c, bid_() >> 3, bid_() & 7, smem);
            } else {
                const int nb = nblk_() - 64, me = bid_() - 64;
                for (int rnd = 0; rnd * nb < 33 * 32; ++rnd) {
                    const int idx = rnd * nb + ((rnd & 1) ? (nb - 1 - me) : me);
                    if (idx < 33 * 32) {
                        const int ch = 32 - idx / 32, rem = idx % 32;
                        e2_item(c, rem >> 2, ch, rem & 3, smem);
                    }
                    __syncthreads();
                }
            }
        } else if (kind == 5) {
            const int tid = tid_(), lane = tid & 63, w = tid >> 6;
            const float gq = wave_maxabs64(p.ev_a_q_norm, lane), gk = wave_maxabs64(p.ev_a_k_norm, lane);
            const float nbl2 = -(8.0f * gq * gk) * LOG2E;
            if (bid_() < 64) xcd_barrier_wait(xb);
            else
            for (int idx = bid_() - 64; idx < 33 * 16; idx += nblk_() - 64) {
                const int ch = 32 - idx / 16, rem = idx % 16;
                const int b = rem >> 1, hg = rem & 1, h = hg * 4 + w;
                hf* Q = c.big + (size_t)(b * LP + ch * 64) * PLD + P_AQ + h * 64;
                const hf* Kb = c.big + (size_t)(b * LP) * PLD + P_AK + h * 64;
                const short* VT = c.avT + ((size_t)(b * 8 + h) * 64) * LP;
                const uint64_t* mrow = c.mask + (size_t)b * 33 * LP + ch * 64;
                attn_wave<0>(Q, PLD, Kb, PLD, VT, ch + 1, 0, mrow, nbl2, 0.f, Q, PLD, lane);
            }
        } else if (kind == 6) {
            gemm_phase<EPI_ODD, 4>(c.h16, 1024, c.W + OFF_WOI, 1280, 1024, c, 0.f, p.od_c_q_norm, p.od_c_k_norm, smem);
        } else if (kind == 7) {
            const int tid = tid_(), lane = tid & 63, w = tid >> 6;
            const float gq = wave_maxabs64(p.od_c_q_norm, lane), gk = wave_maxabs64(p.od_c_k_norm, lane);
            float smax = p.od_c_sinks[lane & 7];
#pragma unroll
            for (int o = 4; o >= 1; o >>= 1) smax = fmaxf(smax, __shfl_xor(smax, o));
            const float bound = fmaxf(8.0f * gq * gk, smax);
            const float nbl2 = -bound * LOG2E;
            for (int idx = bid_(); idx < 528 + 528; idx += nblk_()) {
                if (idx < 528) {
                    const int n = idx / 16, rem = idx % 16;
                    const int b = rem >> 1, g = rem & 1, h = g * 4 + w;
                    hf* Q = c.big + (size_t)(b * LP + n * 64) * P2LD + P2_CQ + h * 64;
                    const hf* Kb = c.big + (size_t)(b * LP) * P2LD + P2_CK + g * 64;
                    const short* VT = c.cvT + ((size_t)(b * 2 + g) * 64) * LP;
                    const int T_first = n - 2 > 1 ? n - 2 : 1;
                    const int nband = n >= T_first ? n - T_first + 1 : 0;
                    const float sink_p = exp2f(p.od_c_sinks[h] * LOG2E + nbl2);
                    attn_wave<1>(Q, P2LD, Kb, P2LD, VT, 1 + nband, T_first, nullptr, nbl2, sink_p, Q, P2LD, lane);
                } else {
                    pool_item(c, idx - 528);
                }
            }
        } else {
            gemm_phase<EPI_FINAL, 3>(c.big, DFF, c.W + OFF_WFO(3), 1024, DFF, c, 0.5f, nullptr, nullptr, smem);
        }
        if (ph < 15 && !(ph == 4 && bid_() < 64)) xcd_barrier(xb);
        if (ph == 0) {
            volatile LAS unsigned* st = (volatile LAS unsigned*)&xb_words;
            const unsigned nloc = __builtin_amdgcn_readfirstlane(st[0]), nx = __builtin_amdgcn_readfirstlane(st[1]);
            if (nx == 8u && nloc * 8u == gridDim.x && xb.x < 8u) { c.xcd = __builtin_amdgcn_readfirstlane((int)xb.x); c.slot = __builtin_amdgcn_readfirstlane((int)st[2]); c.nslots = __builtin_amdgcn_readfirstlane((int)nloc); }
        }
    }
}

extern "C" void kernel_launch(void* const* d_in, const int* in_sizes, int n_in, void* d_out, int out_size, void* d_ws, size_t ws_size,
                              hipStream_t stream) {
    static int grid_blocks = 0;
    if (!grid_blocks) {
        int dev = 0, cus = 0, per_cu = 0;
        hipGetDevice(&dev);
        hipDeviceGetAttribute(&cus, hipDeviceAttributeMultiprocessorCount, dev);
        hipOccupancyMaxActiveBlocksPerMultiprocessor(&per_cu, fwd_megakernel, 256, 0);
        if (per_cu > 2) per_cu = 2;
        if (per_cu < 1) per_cu = 1;
        grid_blocks = cus * per_cu;
    }
    if (ws_size < WS_END) { fprintf(stderr, "workspace too small: %zu < %zu\n", ws_size, (size_t)WS_END); return; }
    Params p{};
    p.x = (const float*)d_in[0]; p.meta = (const float*)d_in[1]; p.ffn1_norm = (const float*)d_in[2];
    p.ffn1_w_in = (const float*)d_in[3]; p.ffn1_w_out = (const float*)d_in[4]; p.mix_norm = (const float*)d_in[5];
    p.ffn2_norm = (const float*)d_in[6]; p.ffn2_w_in = (const float*)d_in[7]; p.ffn2_w_out = (const float*)d_in[8];
    p.ev_w_in = (const float*)d_in[9]; p.ev_a_q_norm = (const float*)d_in[10]; p.ev_a_k_norm = (const float*)d_in[11];
    p.ev_w_out = (const float*)d_in[12]; p.od_w_in = (const float*)d_in[13]; p.od_c_q_norm = (const float*)d_in[14];
    p.od_c_k_norm = (const float*)d_in[15]; p.od_c_sinks = (const float*)d_in[16]; p.od_d_mix = (const float*)d_in[17];
    p.od_d_scale = (const float*)d_in[18]; p.od_w_out = (const float*)d_in[19];
    p.out = (float*)d_out; p.ws = (char*)d_ws;
    hipMemsetAsync((char*)d_ws + WS_BAR, 0, 16384 + 4096, stream);
    void* args[] = {&p};
    hipError_t e = hipLaunchCooperativeKernel((void*)fwd_megakernel, dim3(grid_blocks), dim3(256), args, 0, stream);
    if (e != hipSuccess) fprintf(stderr, "cooperative launch failed: %s (grid %d)\n", hipGetErrorString(e), grid_blocks);
}
```
